# Optimizing an MI355X kernel written in HIP

```python
import jax, jax.numpy as jnp
from jax import lax
import numpy as np

D_MODEL = 1024
BATCH = 16
SEQ = 2048
DEPTH = 1

CONV_WIDTH = D_MODEL
CONV_K = 3
MLA_HEADS = 8
QK_NOPE = 128
QK_ROPE = 64
V_HEAD = 128
Q_LORA = 384
KV_LORA = 256
MLA_WIDTH = MLA_HEADS * V_HEAD
ROPE_THETA = 10000.0
Q_BLOCK = 128
EPS = 1e-6

_SEGMENTS = [CONV_WIDTH, CONV_WIDTH, CONV_WIDTH, CONV_WIDTH,
             Q_LORA, KV_LORA, QK_ROPE, MLA_WIDTH,
             D_MODEL, D_MODEL]
N_IN = int(sum(_SEGMENTS))
SPLIT_POINTS = [int(v) for v in np.cumsum(_SEGMENTS)[:-1]]

kernel_name = "hybrid_conv_mla_gated_merge"


def rms_norm(t, g):
    t32 = t.astype(jnp.float32)
    out = t32 * lax.rsqrt(jnp.mean(t32 * t32, axis=-1, keepdims=True) + EPS) * g.astype(jnp.float32)
    return out.astype(t.dtype)


def rope_tables(positions):
    inv_freq = ROPE_THETA ** (-jnp.arange(0, QK_ROPE, 2, dtype=jnp.float32) / QK_ROPE)
    ang = positions.astype(jnp.float32)[..., None] * inv_freq
    return jnp.cos(ang), jnp.sin(ang)


def apply_rope(t, cos, sin):
    half = t.shape[-1] // 2
    t1, t2 = t[..., :half], t[..., half:]
    cos = cos.astype(t.dtype)
    sin = sin.astype(t.dtype)
    return jnp.concatenate([t1 * cos - t2 * sin, t1 * sin + t2 * cos], axis=-1)


def causal_depthwise_conv(u, w):
    k = w.shape[0]
    s = u.shape[1]
    up = jnp.pad(u, ((0, 0), (k - 1, 0), (0, 0)))
    out = up[:, 0:s] * w[0]
    for j in range(1, k):
        out = out + up[:, j:j + s] * w[j]
    return out


def short_conv_branch(a_v, a_b, a_c, a_z, conv_w, w_conv_out):
    y = a_b * causal_depthwise_conv(a_c * a_v, conv_w)
    y = y * jax.nn.silu(a_z)
    return y @ w_conv_out


def causal_mla_attention(q_nope, q_pe, k_nope, k_pe, v):
    s_len = q_nope.shape[1]
    scale = (QK_NOPE + QK_ROPE) ** -0.5
    outs = []
    for i in range(s_len // Q_BLOCK):
        q0, q1 = i * Q_BLOCK, (i + 1) * Q_BLOCK
        sc = (jnp.einsum('bqhd,bkhd->bhqk', q_nope[:, q0:q1], k_nope[:, :q1])
              + jnp.einsum('bqhr,bkr->bhqk', q_pe[:, q0:q1], k_pe[:, :q1]))
        sc = sc.astype(jnp.float32) * scale
        qpos = jnp.arange(q0, q1)[:, None]
        kpos = jnp.arange(q1)[None, :]
        sc = jnp.where(kpos <= qpos, sc, -jnp.inf)
        p = jax.nn.softmax(sc, axis=-1).astype(v.dtype)
        outs.append(jnp.einsum('bhqk,bkhd->bqhd', p, v[:, :q1]))
    return jnp.concatenate(outs, axis=1)


def mla_branch(q_lat, kv_lat, k_rope, b_z, cos, sin, g_q, w_uq, g_kv, w_ukv, w_mla_out):
    bsz, s_len = q_lat.shape[0], q_lat.shape[1]
    q = (rms_norm(q_lat, g_q) @ w_uq).reshape(bsz, s_len, MLA_HEADS, QK_NOPE + QK_ROPE)
    q_nope = q[..., :QK_NOPE]
    q_pe = apply_rope(q[..., QK_NOPE:], cos[:, :, None, :], sin[:, :, None, :])
    kv = (rms_norm(kv_lat, g_kv) @ w_ukv).reshape(bsz, s_len, MLA_HEADS, QK_NOPE + V_HEAD)
    k_nope = kv[..., :QK_NOPE]
    v = kv[..., QK_NOPE:]
    k_pe = apply_rope(k_rope, cos, sin)
    o = causal_mla_attention(q_nope, q_pe, k_nope, k_pe, v).reshape(bsz, s_len, MLA_WIDTH)
    o = o * jax.nn.silu(b_z)
    return o @ w_mla_out


def setup_inputs(seed: int = 0) -> dict:
    key = jax.random.key(seed)
    ks = jax.random.split(key, 20)
    f32 = jnp.float32

    def w(k, shape, fan_in):
        return jax.random.normal(k, shape, f32) * (fan_in ** -0.5)

    def gain(k, shape):
        return 1.0 + 0.01 * jax.random.normal(k, shape, f32)

    x = jax.random.normal(ks[0], (BATCH, SEQ, D_MODEL), f32)
    c = jax.random.normal(ks[1], (BATCH, D_MODEL), f32)
    positions = jnp.broadcast_to(jnp.arange(SEQ, dtype=jnp.int32)[None, :], (BATCH, SEQ))
    return {
        "x": x,
        "c": c,
        "positions": positions,
        "w_ada": w(ks[2], (DEPTH, D_MODEL, 3 * D_MODEL), D_MODEL) * 0.1,
        "b_ada": 0.01 * jax.random.normal(ks[3], (DEPTH, 3 * D_MODEL), f32),
        "g_pre": gain(ks[4], (DEPTH, D_MODEL)),
        "w_in": w(ks[5], (DEPTH, D_MODEL, N_IN), D_MODEL),
        "conv_w": w(ks[6], (DEPTH, CONV_K, CONV_WIDTH), CONV_K),
        "w_conv_out": w(ks[7], (DEPTH, CONV_WIDTH, D_MODEL), CONV_WIDTH),
        "g_q": gain(ks[8], (DEPTH, Q_LORA)),
        "w_uq": w(ks[9], (DEPTH, Q_LORA, MLA_HEADS * (QK_NOPE + QK_ROPE)), Q_LORA),
        "g_kv": gain(ks[10], (DEPTH, KV_LORA)),
        "w_ukv": w(ks[11], (DEPTH, KV_LORA, MLA_HEADS * (QK_NOPE + V_HEAD)), KV_LORA),
        "w_mla_out": w(ks[12], (DEPTH, MLA_WIDTH, D_MODEL), MLA_WIDTH),
        "w_out": w(ks[13], (DEPTH, D_MODEL, D_MODEL), D_MODEL),
        "g_post": gain(ks[14], (DEPTH, D_MODEL)),
    }


def reference(x, c, positions, w_ada, b_ada, g_pre, w_in, conv_w, w_conv_out,
              g_q, w_uq, g_kv, w_ukv, w_mla_out, w_out, g_post):
    cos, sin = rope_tables(positions)
    for l in range(DEPTH):
        mod = c @ w_ada[l] + b_ada[l]
        shift, scale, gate = jnp.split(mod, 3, axis=-1)
        h = rms_norm(x, g_pre[l]) * (1.0 + scale[:, None, :]) + shift[:, None, :]
        proj = h @ w_in[l]
        (a_v, a_b, a_c, a_z, q_lat, kv_lat, k_rope, b_z,
         gate_a, gate_b) = jnp.split(proj, SPLIT_POINTS, axis=-1)
        y_a = short_conv_branch(a_v, a_b, a_c, a_z, conv_w[l], w_conv_out[l])
        y_b = mla_branch(q_lat, kv_lat, k_rope, b_z, cos, sin,
                         g_q[l], w_uq[l], g_kv[l], w_ukv[l], w_mla_out[l])
        m = jax.nn.sigmoid(gate_a) * y_a + jax.nn.sigmoid(gate_b) * y_b
        o = m @ w_out[l]
        x = x + gate[:, None, :] * rms_norm(o, g_post[l])
    return x
```

```cpp
#include <hip/hip_runtime.h>
#include <hip/hip_cooperative_groups.h>
#include <cstdio>
#include <cstdint>
namespace cg = cooperative_groups;
namespace pg8 {
#define PG8_LAS __attribute__((address_space(3)))
typedef unsigned short bf16_t;
typedef short bf16x8 __attribute__((ext_vector_type(8)));
typedef float f32x4 __attribute__((ext_vector_type(4)));
typedef unsigned u32x4 __attribute__((ext_vector_type(4)));
constexpr int BM = 256, BK = 64, HALF = 128, HTB = HALF * BK * 2  , STAGE_BYTES = 8 * HTB, NXCD = 8, WGM = 8;

__host__ __device__ __forceinline__ int lds_byte(int r, int c) { const int st = (r >> 4) * 2 + (c >> 5), rr = r & 15, cc = c & 31, ob = rr * 64 + cc * 2; return st * 1024 + (ob ^ (((ob >> 9) & 1) << 5)); }
__host__ __device__ __forceinline__ void stage_rc(int b, int& R, int& C) { const int st = b / 1024, sb = b % 1024, swz = sb ^ (((sb >> 9) & 1) << 5); R = (st >> 1) * 16 + swz / 64; C = (st & 1) * 32 + (swz % 64) / 2; }
__host__ __device__ __forceinline__ int perm32(int rho) { const int n = rho >> 4, i = rho & 15; return 8 * (i >> 2) + 4 * n + (i & 3); }

struct Unit { int pm, pn; };
struct Gemm { const bf16_t* A; const bf16_t* Bt; int M, N, K; };

struct StaticOrder {
    int nM, nN, nwg, G, c;
    __host__ __device__ void init(int M, int N, int G_, int c_) { nM = M / BM; nN = N / BM; nwg = nM * nN; G = G_; c = c_; }
    __host__ __device__ bool next(int i, Unit& u) const {
        const long L = (long)i * G + c; if (L >= nwg) return false;
        int wgid = (int)L; { const int q = nwg / NXCD, r = nwg % NXCD, xcd = wgid % NXCD, off = wgid / NXCD; wgid = (xcd < r ? xcd * (q + 1) : r * (q + 1) + (xcd - r) * q) + off; }
        const int nig = WGM * nN, gid = wgid / nig, fm = gid * WGM, gsz = (nM - fm) < WGM ? (nM - fm) : WGM;
        u.pm = fm + ((wgid % nig) % gsz); u.pn = (wgid % nig) / gsz; return true;
    }
    __device__ __forceinline__ void a_ready(const Unit&) const {}
    __device__ __forceinline__ void done(const Unit&) const {}
};

template <class Epi, class Sched, bool ALIGN_EPI = false, bool SP2 = false>
__device__ __forceinline__ void gemm_phase(PG8_LAS unsigned char* lds, const Gemm g, const Sched& S, const Epi& E) {
    const int tid = threadIdx.x, wid = __builtin_amdgcn_readfirstlane(tid >> 6), lane = tid & 63, wr = wid >> 2, wc = wid & 3, fr = lane & 15, fq = lane >> 4;
    int Kv_ = g.K; asm volatile("" : "+s"(Kv_)); const int K = Kv_, nt = K / BK;
    unsigned voffA[2], voffB[2];
#pragma unroll
    for (int i = 0; i < 2; ++i) { int R, C; stage_rc(tid * 16 + i * 8192, R, C); const int Rb = Epi::PERM ? ((R & ~31) + perm32(R & 31)) : R;
        voffA[i] = (unsigned)(R * K + C) * 2u; voffB[i] = (unsigned)(Rb * K + C) * 2u; }
    const size_t kstep = (size_t)(BK * 2);
    const size_t hstep = (size_t)HALF * K * 2;
    const size_t tstep = 2 * hstep;
    const unsigned ldsw = (unsigned)wid * 1024u;
    const int aoff = lds_byte(wr * 64 + fr, fq * 8), boff = lds_byte(wc * 32 + fr, fq * 8);
#define PG8_SA(b, h) (((b) * 2 + (h)) * HTB)
#define PG8_SB(b, h) ((4 + (b) * 2 + (h)) * HTB)
#define PG8_STAGE(bufoff, gbase, voff) do { _Pragma("unroll") for (int _i = 0; _i < 2; ++_i) \
        __builtin_amdgcn_global_load_lds((const unsigned*)((const char*)(gbase) + (voff)[_i]), (PG8_LAS unsigned*)(lds + (bufoff) + ldsw + _i * 8192), 16, 0, 0); } while (0)
#define PG8_LDA(dst, b, h) do { _Pragma("unroll") for (int m = 0; m < 4; ++m) _Pragma("unroll") for (int k = 0; k < 2; ++k) dst[m][k] = *(const PG8_LAS bf16x8*)(lds + PG8_SA(b, h) + aoff + m * 2048 + k * 1024); } while (0)
#define PG8_LDB(dst, b, h) do { _Pragma("unroll") for (int n = 0; n < 2; ++n) _Pragma("unroll") for (int k = 0; k < 2; ++k) dst[n][k] = *(const PG8_LAS bf16x8*)(lds + PG8_SB(b, h) + boff + n * 2048 + k * 1024); } while (0)
#define PG8_MMA(ai, bj, At, Bt) do { __builtin_amdgcn_s_setprio(1); _Pragma("unroll") for (int m = 0; m < 4; ++m) _Pragma("unroll") for (int n = 0; n < 2; ++n) _Pragma("unroll") for (int k = 0; k < 2; ++k) \
        acc[ai][bj][m][n] = __builtin_amdgcn_mfma_f32_16x16x32_bf16(Bt[n][k], At[m][k], acc[ai][bj][m][n], 0, 0, 0); __builtin_amdgcn_s_setprio(0); } while (0)
#define PG8_WAIT_V(n) asm volatile("s_waitcnt vmcnt(" #n ")" ::: "memory")
#define PG8_WAIT_L(n) asm volatile("s_waitcnt lgkmcnt(" #n ")" ::: "memory")
#define PG8_BAR __builtin_amdgcn_s_barrier()
#define PG8_SCHED __builtin_amdgcn_sched_barrier(0)
    Unit cur, nxt; int ui = 0;
    if (!S.next(0, cur)) return;
    f32x4 acc[2][2][4][2];
#pragma unroll
    for (int a = 0; a < 2; ++a)
#pragma unroll
        for (int b = 0; b < 2; ++b)
#pragma unroll
            for (int m = 0; m < 4; ++m)
#pragma unroll
                for (int n = 0; n < 2; ++n) acc[a][b][m][n] = (f32x4){0.f, 0.f, 0.f, 0.f};
    bf16x8 At[4][2], B0[2][2], B1[2][2];
    const char* cA = (const char*)g.A + (size_t)cur.pm * tstep; const char* cB = (const char*)g.Bt + (size_t)cur.pn * tstep;
    S.a_ready(cur);
    if constexpr (SP2) {
        PG8_STAGE(PG8_SB(0, 0), cB, voffB); PG8_STAGE(PG8_SB(0, 1), cB + hstep, voffB); PG8_STAGE(PG8_SA(0, 0), cA, voffA); PG8_STAGE(PG8_SA(0, 1), cA + hstep, voffA);
        if (wr == 1) PG8_BAR;
        PG8_WAIT_V(2); PG8_BAR;
        PG8_STAGE(PG8_SB(1, 0), cB + kstep, voffB); PG8_STAGE(PG8_SA(1, 0), cA + kstep, voffA); PG8_STAGE(PG8_SB(1, 1), cB + hstep + kstep, voffB);
        PG8_WAIT_V(6); PG8_BAR;
    } else {
        PG8_STAGE(PG8_SB(0, 0), cB, voffB); PG8_STAGE(PG8_SA(0, 0), cA, voffA); PG8_STAGE(PG8_SB(0, 1), cB + hstep, voffB); PG8_STAGE(PG8_SA(0, 1), cA + hstep, voffA);
        if (wr == 1) PG8_BAR;
        PG8_WAIT_V(4); PG8_BAR;
        PG8_STAGE(PG8_SB(1, 0), cB + kstep, voffB); PG8_STAGE(PG8_SA(1, 0), cA + kstep, voffA); PG8_STAGE(PG8_SB(1, 1), cB + hstep + kstep, voffB);
        PG8_WAIT_V(6); PG8_BAR;
    }
    for (;;) {
        const bool has_next = S.next(ui + 1, nxt);
        const char* nA = has_next ? (const char*)g.A + (size_t)nxt.pm * tstep : cA; const char* nB = has_next ? (const char*)g.Bt + (size_t)nxt.pn * tstep : cB;
        for (int t = 0; t < nt; t += 2) {
            if constexpr (Epi::HAS_MID) { if (t == Epi::MID_T) E.mid(acc, cur, wr, wc, fr, fq); }
            const bool last = (t == nt - 2);
            const char* a1 = cA + (size_t)(t + 1) * kstep;
            const char* a2 = last ? nA : cA + (size_t)(t + 2) * kstep; const char* b2 = last ? nB : cB + (size_t)(t + 2) * kstep;
            const char* a3 = a2 + kstep; const char* b3 = b2 + kstep;
            if (last && has_next) S.a_ready(nxt);
            if constexpr (SP2) {
            PG8_LDB(B0, 0, 0); PG8_LDB(B1, 0, 1); PG8_SCHED; PG8_LDA(At, 0, 0); PG8_STAGE(PG8_SA(1, 1), a1 + hstep, voffA);
            PG8_WAIT_V(8); PG8_WAIT_L(0); PG8_BAR; PG8_MMA(0, 0, At, B0); PG8_MMA(0, 1, At, B1); PG8_BAR; PG8_SCHED;
            PG8_LDA(At, 0, 1); PG8_STAGE(PG8_SB(0, 0), b2, voffB); PG8_STAGE(PG8_SB(0, 1), b2 + hstep, voffB); PG8_STAGE(PG8_SA(0, 0), a2, voffA);
            PG8_WAIT_V(8); PG8_WAIT_L(0); PG8_BAR; PG8_MMA(1, 0, At, B0); PG8_MMA(1, 1, At, B1); PG8_BAR; PG8_SCHED;
            PG8_LDB(B0, 1, 0); PG8_LDB(B1, 1, 1); PG8_SCHED; PG8_LDA(At, 1, 0); PG8_STAGE(PG8_SA(0, 1), a2 + hstep, voffA);
            PG8_WAIT_V(8); PG8_WAIT_L(0); PG8_BAR; PG8_MMA(0, 0, At, B0); PG8_MMA(0, 1, At, B1); PG8_BAR; PG8_SCHED;
            PG8_LDA(At, 1, 1); PG8_STAGE(PG8_SB(1, 0), b3, voffB); PG8_STAGE(PG8_SB(1, 1), b3 + hstep, voffB); PG8_STAGE(PG8_SA(1, 0), a3, voffA);
            PG8_WAIT_V(8); PG8_WAIT_L(0); PG8_BAR; PG8_MMA(1, 0, At, B0); PG8_MMA(1, 1, At, B1); PG8_BAR; PG8_SCHED;
            } else {
            PG8_LDB(B0, 0, 0); PG8_SCHED; PG8_LDA(At, 0, 0); PG8_STAGE(PG8_SA(1, 1), a1 + hstep, voffA);
            PG8_WAIT_L(8); PG8_BAR; PG8_WAIT_L(0); PG8_MMA(0, 0, At, B0); PG8_BAR; PG8_SCHED;
            PG8_LDB(B1, 0, 1); PG8_STAGE(PG8_SB(0, 0), b2, voffB);
            PG8_BAR; PG8_WAIT_L(0); PG8_MMA(0, 1, At, B1); PG8_BAR;
            PG8_LDA(At, 0, 1); PG8_STAGE(PG8_SA(0, 0), a2, voffA);
            PG8_BAR; PG8_WAIT_L(0); PG8_MMA(1, 0, At, B0); PG8_BAR; PG8_SCHED;
            PG8_STAGE(PG8_SB(0, 1), b2 + hstep, voffB);
            PG8_WAIT_V(6); PG8_BAR; PG8_MMA(1, 1, At, B1); PG8_BAR;
            PG8_LDB(B0, 1, 0); PG8_SCHED; PG8_LDA(At, 1, 0); PG8_STAGE(PG8_SA(0, 1), a2 + hstep, voffA);
            PG8_WAIT_L(8); PG8_BAR; PG8_WAIT_L(0); PG8_MMA(0, 0, At, B0); PG8_BAR; PG8_SCHED;
            PG8_LDB(B1, 1, 1); PG8_STAGE(PG8_SB(1, 0), b3, voffB);
            PG8_BAR; PG8_WAIT_L(0); PG8_MMA(0, 1, At, B1); PG8_BAR;
            PG8_LDA(At, 1, 1); PG8_STAGE(PG8_SA(1, 0), a3, voffA);
            PG8_BAR; PG8_WAIT_L(0); PG8_MMA(1, 0, At, B0); PG8_BAR; PG8_SCHED;
            PG8_STAGE(PG8_SB(1, 1), b3 + hstep, voffB);
            PG8_WAIT_V(6); PG8_BAR; PG8_MMA(1, 1, At, B1); PG8_BAR;
            }
        }
        if constexpr (ALIGN_EPI) { if (wr == 0) PG8_BAR; }
        if constexpr (!Epi::AFTER_DRAIN) { E(acc, cur, wr, wc, fr, fq); S.done(cur); }
        if (!has_next) break;
#pragma unroll
        for (int a = 0; a < 2; ++a)
#pragma unroll
            for (int b = 0; b < 2; ++b)
#pragma unroll
                for (int m = 0; m < 4; ++m)
#pragma unroll
                    for (int n = 0; n < 2; ++n) acc[a][b][m][n] = (f32x4){0.f, 0.f, 0.f, 0.f};
        cur = nxt; cA = nA; cB = nB; ++ui;
        if constexpr (ALIGN_EPI) { if (wr == 1) PG8_BAR; }
    }
    PG8_WAIT_V(0);
    if constexpr (!ALIGN_EPI) { if (wr == 0) PG8_BAR; }
    PG8_BAR;
    if constexpr (Epi::AFTER_DRAIN) { E.fused(acc, cur, wr, wc, fr, fq, lds, wid, lane); S.done(cur); }
#undef PG8_SA
#undef PG8_SB
#undef PG8_STAGE
#undef PG8_LDA
#undef PG8_LDB
#undef PG8_MMA
#undef PG8_WAIT_V
#undef PG8_WAIT_L
#undef PG8_BAR
#undef PG8_SCHED
}
}
#define LAS __attribute__((address_space(3)))
#define GAS __attribute__((address_space(1)))
using pg8::bf16_t; using pg8::bf16x8; using pg8::f32x4; using pg8::u32x4; using pg8::Unit;
typedef float f32x16 __attribute__((ext_vector_type(16)));
typedef unsigned u32x2 __attribute__((ext_vector_type(2)));
typedef float f32x2_t __attribute__((ext_vector_type(2)));
typedef __bf16 bf16x2_t __attribute__((ext_vector_type(2)));
typedef short v4i16_t __attribute__((ext_vector_type(4)));

constexpr int DM = 1024, NB = 16, SEQ = 2048, T = NB * SEQ;
constexpr int NH = 8, QLORA = 384, KVLORA = 256, NIN = 7872, NINV = 7936;
constexpr float EPS = 1e-6f;
constexpr float QSCALE = 0.07216878364870322f * 1.4426950408889634f;

constexpr size_t MiB = 1u << 20;
constexpr size_t WS_SSQ = 0;
constexpr size_t WS_BAR = 448 * 1024;
constexpr size_t WS_MOD = 512 * 1024;
constexpr size_t WS_ROPE = 1 * MiB;
constexpr size_t WS_WIN = 9 * MiB, WS_WM = 25 * MiB, WS_WUQ = 29 * MiB, WS_WUKV = 30 * MiB + 512 * 1024, WS_WOUT = 32 * MiB;
constexpr size_t WS_KPE = 34 * MiB, WS_QL = 38 * MiB, WS_KVL = 62 * MiB;
constexpr size_t WS_RA = 80 * MiB;
constexpr size_t WS_RB = 144 * MiB;
constexpr size_t WS_A2 = 208 * MiB;
constexpr size_t WS_QIMG = 336 * MiB, WS_VIMG = 432 * MiB, WS_END = 496 * MiB;
constexpr size_t WS_H = WS_QIMG;

constexpr int LDS_BYTES = 147456 + 256;

__device__ __forceinline__ unsigned pk2(float lo, float hi) { f32x2_t v = {lo, hi}; bf16x2_t b = __builtin_convertvector(v, bf16x2_t); return __builtin_bit_cast(unsigned, b); }
__device__ __forceinline__ u32x4 pk8(f32x4 a, f32x4 b) { u32x4 w; w.x = pk2(a[0], a[1]); w.y = pk2(a[2], a[3]); w.z = pk2(b[0], b[1]); w.w = pk2(b[2], b[3]); return w; }
__device__ __forceinline__ float bf_lo(unsigned w) { return __uint_as_float(w << 16); }
__device__ __forceinline__ float bf_hi(unsigned w) { return __uint_as_float(w & 0xffff0000u); }
__device__ __forceinline__ float sigmoidf_(float x) { return __builtin_amdgcn_rcpf(1.0f + __expf(-x)); }
__device__ __forceinline__ f32x4 silu4(f32x4 x) { f32x4 r; for (int i = 0; i < 4; ++i) r[i] = x[i] * sigmoidf_(x[i]); return r; }
__device__ __forceinline__ float sumsq4(f32x4 x) { return (x[0] * x[0] + x[1] * x[1]) + (x[2] * x[2] + x[3] * x[3]); }
__device__ __forceinline__ void st16(bf16_t* p, u32x4 v) { __builtin_nontemporal_store(v, (u32x4*)p); }
__device__ __forceinline__ void st16c(bf16_t* p, u32x4 v) { *(u32x4*)p = v; }

#define ROW_OF(ai, m) (u.pm * 256 + (ai) * 128 + wr * 64 + (m) * 16 + fr)
typedef f32x4 AccT[2][2][4][2];

struct EpiInProj {
    static constexpr bool PERM = true, AFTER_DRAIN = false, HAS_MID = false; static constexpr int MID_T = 0;
    unsigned char* ws; float* out;
    __device__ __forceinline__ void mid(AccT&, const Unit&, int, int, int, int) const {}
    __device__ __forceinline__ void operator()(const AccT& acc, const Unit& u, int wr, int wc, int fr_, int fq_) const {
        int fr = fr_, fq = fq_; asm volatile("" : "+v"(fr), "+v"(fq));
        const int pn = u.pn < 8 ? u.pn : u.pn + 8, cb = wc * 32 + 8 * fq;
        bf16_t* const U = (bf16_t*)(ws + WS_RB); bf16_t* const A2 = (bf16_t*)(ws + WS_A2); bf16_t* const QL = (bf16_t*)(ws + WS_QL); bf16_t* const KVL = (bf16_t*)(ws + WS_KVL); bf16_t* const KPE = (bf16_t*)(ws + WS_KPE);
        bf16_t* const R = (bf16_t*)out; bf16_t* const SB = (bf16_t*)out + (size_t)T * 1024; float* const ssq_q = (float*)(ws + WS_SSQ); float* const ssq_kv = ssq_q + T; const float* const rope = (const float*)(ws + WS_ROPE);
#pragma unroll
        for (int ai = 0; ai < 2; ++ai)
#pragma unroll
            for (int m = 0; m < 4; ++m) {
                const size_t row = (size_t)ROW_OF(ai, m);
                const f32x4 a0 = acc[ai][0][m][0], a1 = acc[ai][0][m][1], b0 = acc[ai][1][m][0], b1 = acc[ai][1][m][1];
                if (pn < 8) {
                    st16c(U + row * 1024 + pn * 128 + cb, pk8(a0 * b0, a1 * b1));
                } else if (pn == 16) {
                    st16c(QL + row * 384 + cb, pk8(a0, a1)); st16c(QL + row * 384 + 128 + cb, pk8(b0, b1));
                    float s = (sumsq4(a0) + sumsq4(a1)) + (sumsq4(b0) + sumsq4(b1));
                    s += __shfl_xor(s, 16); s += __shfl_xor(s, 32);
                    if (fq == 0) atomicAdd(ssq_q + row, s);
                } else if (pn == 17) {
                    st16c(QL + row * 384 + 256 + cb, pk8(a0, a1)); st16c(KVL + row * 256 + cb, pk8(b0, b1));
                    float s = sumsq4(a0) + sumsq4(a1), s2 = sumsq4(b0) + sumsq4(b1);
                    s += __shfl_xor(s, 16); s += __shfl_xor(s, 32); s2 += __shfl_xor(s2, 16); s2 += __shfl_xor(s2, 32);
                    if (fq == 0) { atomicAdd(ssq_q + row, s); atomicAdd(ssq_kv + row, s2); }
                } else if (pn == 18) {
                    if (wc < 2) {
                        st16c(KVL + row * 256 + 128 + cb, pk8(a0, a1)); st16c(KVL + row * 256 + 192 + cb, pk8(b0, b1));
                        float s = (sumsq4(a0) + sumsq4(a1)) + (sumsq4(b0) + sumsq4(b1));
                        s += __shfl_xor(s, 16); s += __shfl_xor(s, 32);
                        if (fq == 0) atomicAdd(ssq_kv + row, s);
                    } else if (wc == 2) {
                        const f32x4* cs = (const f32x4*)(rope + row * 64 + 16 * fq);
                        const f32x4 c0 = cs[0], c1 = cs[1], c2 = cs[2], c3 = cs[3];
                        f32x4 o1a, o1b, o2a, o2b;
                        o1a[0] = a0[0] * c0[0] - b0[0] * c0[1]; o2a[0] = a0[0] * c0[1] + b0[0] * c0[0];
                        o1a[1] = a0[1] * c0[2] - b0[1] * c0[3]; o2a[1] = a0[1] * c0[3] + b0[1] * c0[2];
                        o1a[2] = a0[2] * c1[0] - b0[2] * c1[1]; o2a[2] = a0[2] * c1[1] + b0[2] * c1[0];
                        o1a[3] = a0[3] * c1[2] - b0[3] * c1[3]; o2a[3] = a0[3] * c1[3] + b0[3] * c1[2];
                        o1b[0] = a1[0] * c2[0] - b1[0] * c2[1]; o2b[0] = a1[0] * c2[1] + b1[0] * c2[0];
                        o1b[1] = a1[1] * c2[2] - b1[1] * c2[3]; o2b[1] = a1[1] * c2[3] + b1[1] * c2[2];
                        o1b[2] = a1[2] * c3[0] - b1[2] * c3[1]; o2b[2] = a1[2] * c3[1] + b1[2] * c3[0];
                        o1b[3] = a1[3] * c3[2] - b1[3] * c3[3]; o2b[3] = a1[3] * c3[3] + b1[3] * c3[2];
                        bf16_t* base = KPE + (row >> 5) * 2048 + (row & 31) * 8 + (fq & 1) * 256;
                        st16(base + (fq >> 1) * 512, pk8(o1a, o1b)); st16(base + (2 + (fq >> 1)) * 512, pk8(o2a, o2b));
                    }
                } else if (pn < 23) {
                    bf16_t* p = A2 + row * 2048 + 1024 + (pn - 19) * 256 + cb;
                    st16(p, pk8(silu4(a0), silu4(a1))); st16(p + 128, pk8(silu4(b0), silu4(b1)));
                } else {
                    f32x4 r0, r1, s0, s1;
#pragma unroll
                    for (int j = 0; j < 4; ++j) {
                        const float ea0 = 1.0f + __expf(-a0[j]), eb0 = 1.0f + __expf(-b0[j]), ea1 = 1.0f + __expf(-a1[j]), eb1 = 1.0f + __expf(-b1[j]);
                        s0[j] = __builtin_amdgcn_rcpf(eb0); s1[j] = __builtin_amdgcn_rcpf(eb1);
                        r0[j] = eb0 * __builtin_amdgcn_rcpf(ea0); r1[j] = eb1 * __builtin_amdgcn_rcpf(ea1);
                    }
                    st16(R + row * 1024 + (pn - 23) * 128 + cb, pk8(r0, r1)); st16(SB + row * 1024 + (pn - 23) * 128 + cb, pk8(s0, s1));
                }
            }
    }
};

struct EpiConv {
    static constexpr bool PERM = true, AFTER_DRAIN = false, HAS_MID = false; static constexpr int MID_T = 0;
    unsigned char* ws; const float* conv_w;
    __device__ __forceinline__ void mid(AccT&, const Unit&, int, int, int, int) const {}
    __device__ __forceinline__ void operator()(const AccT& acc, const Unit& u, int wr, int wc, int fr_, int fq_) const {
        int fr = fr_, fq = fq_; asm volatile("" : "+v"(fr), "+v"(fq));
        const int c0 = u.pn * 128 + wc * 32 + 8 * fq;
        const bf16_t* const U = (const bf16_t*)(ws + WS_RB); bf16_t* const A2 = (bf16_t*)(ws + WS_A2);
        const f32x4 w0a = *(const f32x4*)(conv_w + c0), w0b = *(const f32x4*)(conv_w + c0 + 4);
        const f32x4 w1a = *(const f32x4*)(conv_w + 1024 + c0), w1b = *(const f32x4*)(conv_w + 1024 + c0 + 4);
        const f32x4 w2a = *(const f32x4*)(conv_w + 2048 + c0), w2b = *(const f32x4*)(conv_w + 2048 + c0 + 4);
#pragma unroll
        for (int ai = 0; ai < 2; ++ai) {
            u32x4 uu[4][3];
#pragma unroll
            for (int m = 0; m < 4; ++m) { const size_t row = (size_t)ROW_OF(ai, m); const int s = (int)(row & 2047); const u32x4 z4 = {0u, 0u, 0u, 0u};
                uu[m][2] = *(const u32x4*)(U + row * 1024 + c0);
                uu[m][1] = s >= 1 ? *(const u32x4*)(U + (row - 1) * 1024 + c0) : z4;
                uu[m][0] = s >= 2 ? *(const u32x4*)(U + (row - 2) * 1024 + c0) : z4; }
#pragma unroll
            for (int m = 0; m < 4; ++m) { const size_t row = (size_t)ROW_OF(ai, m);
                const u32x4 u0 = uu[m][0], u1 = uu[m][1], u2 = uu[m][2];
                const f32x4 ga = acc[ai][0][m][0] * silu4(acc[ai][1][m][0]), gb = acc[ai][0][m][1] * silu4(acc[ai][1][m][1]);
                const f32x4 ca = w0a * (f32x4){bf_lo(u0.x), bf_hi(u0.x), bf_lo(u0.y), bf_hi(u0.y)} + w1a * (f32x4){bf_lo(u1.x), bf_hi(u1.x), bf_lo(u1.y), bf_hi(u1.y)} + w2a * (f32x4){bf_lo(u2.x), bf_hi(u2.x), bf_lo(u2.y), bf_hi(u2.y)};
                const f32x4 cbv = w0b * (f32x4){bf_lo(u0.z), bf_hi(u0.z), bf_lo(u0.w), bf_hi(u0.w)} + w1b * (f32x4){bf_lo(u1.z), bf_hi(u1.z), bf_lo(u1.w), bf_hi(u1.w)} + w2b * (f32x4){bf_lo(u2.z), bf_hi(u2.z), bf_lo(u2.w), bf_hi(u2.w)};
                st16(A2 + row * 2048 + c0, pk8(ga * ca, gb * cbv)); }
            asm volatile("" ::: "memory");
        }
    }
};

struct EpiQUp {
    static constexpr bool PERM = true, AFTER_DRAIN = false, HAS_MID = false; static constexpr int MID_T = 0;
    unsigned char* ws;
    __device__ __forceinline__ void mid(AccT&, const Unit&, int, int, int, int) const {}
    __device__ __forceinline__ void operator()(const AccT& acc, const Unit& u, int wr, int wc, int fr_, int fq_) const {
        int fr = fr_, fq = fq_; asm volatile("" : "+v"(fr), "+v"(fq));
        const int pn = u.pn;
        bf16_t* const QI = (bf16_t*)(ws + WS_QIMG); const float* const ssq_q = (const float*)(ws + WS_SSQ); const float* const rope = (const float*)(ws + WS_ROPE);
        float ssv[2][4];
#pragma unroll
        for (int ai = 0; ai < 2; ++ai)
#pragma unroll
            for (int m = 0; m < 4; ++m) ssv[ai][m] = ssq_q[(size_t)ROW_OF(ai, m)];
#pragma unroll
        for (int aim = 0; aim < 4; ++aim) { const int ai = aim >> 1;
            f32x4 cs[4][4];
            if (pn >= 4) {
#pragma unroll
                for (int m = 2 * (aim & 1); m < 2 * (aim & 1) + 2; ++m) { const f32x4* cp = (const f32x4*)(rope + (size_t)ROW_OF(ai, m) * 64 + 16 * fq);
#pragma unroll
                    for (int j = 0; j < 4; ++j) cs[m][j] = cp[j]; }
            }
#pragma unroll
            for (int m = 2 * (aim & 1); m < 2 * (aim & 1) + 2; ++m) {
                const size_t row = (size_t)ROW_OF(ai, m);
                const float sc = QSCALE * __builtin_amdgcn_rsqf(ssv[ai][m] * (1.0f / QLORA) + EPS);
                const int b = (int)(row >> 11), s = (int)(row & 2047);
                const f32x4 a0 = acc[ai][0][m][0] * sc, a1 = acc[ai][0][m][1] * sc, b0 = acc[ai][1][m][0] * sc, b1 = acc[ai][1][m][1] * sc;
                if (pn < 4) {
                    const int ks = 2 * wc + (fq >> 1), h = fq & 1;
                    bf16_t* p = QI + ((size_t)((b * 8 + 2 * pn) * 64 + (s >> 5))) * 6144 + (ks * 2 + h) * 256 + (s & 31) * 8;
                    st16(p, pk8(a0, a1)); st16(p + (size_t)64 * 6144, pk8(b0, b1));
                } else {
                    const int head = 4 * (pn - 4) + wc;
                    const f32x4 c0 = cs[m][0], c1 = cs[m][1], c2 = cs[m][2], c3 = cs[m][3];
                    f32x4 o1a, o1b, o2a, o2b;
                    o1a[0] = a0[0] * c0[0] - b0[0] * c0[1]; o2a[0] = a0[0] * c0[1] + b0[0] * c0[0];
                    o1a[1] = a0[1] * c0[2] - b0[1] * c0[3]; o2a[1] = a0[1] * c0[3] + b0[1] * c0[2];
                    o1a[2] = a0[2] * c1[0] - b0[2] * c1[1]; o2a[2] = a0[2] * c1[1] + b0[2] * c1[0];
                    o1a[3] = a0[3] * c1[2] - b0[3] * c1[3]; o2a[3] = a0[3] * c1[3] + b0[3] * c1[2];
                    o1b[0] = a1[0] * c2[0] - b1[0] * c2[1]; o2b[0] = a1[0] * c2[1] + b1[0] * c2[0];
                    o1b[1] = a1[1] * c2[2] - b1[1] * c2[3]; o2b[1] = a1[1] * c2[3] + b1[1] * c2[2];
                    o1b[2] = a1[2] * c3[0] - b1[2] * c3[1]; o2b[2] = a1[2] * c3[1] + b1[2] * c3[0];
                    o1b[3] = a1[3] * c3[2] - b1[3] * c3[3]; o2b[3] = a1[3] * c3[3] + b1[3] * c3[2];
                    bf16_t* p = QI + ((size_t)((b * 8 + head) * 64 + (s >> 5))) * 6144 + (fq & 1) * 256 + (s & 31) * 8;
                    st16(p + (8 + (fq >> 1)) * 512, pk8(o1a, o1b)); st16(p + (10 + (fq >> 1)) * 512, pk8(o2a, o2b));
                }
            }
            asm volatile("" ::: "memory");
        }
    }
};

struct EpiKVUp {
    static constexpr bool PERM = true, AFTER_DRAIN = false, HAS_MID = false; static constexpr int MID_T = 0;
    unsigned char* ws;
    __device__ __forceinline__ void mid(AccT&, const Unit&, int, int, int, int) const {}
    __device__ __forceinline__ void operator()(const AccT& acc, const Unit& u, int wr, int wc, int fr_, int fq_) const {
        int fr = fr_, fq = fq_; asm volatile("" : "+v"(fr), "+v"(fq));
        const int pn = u.pn;
        bf16_t* const KN = (bf16_t*)(ws + WS_RA); bf16_t* const VI = (bf16_t*)(ws + WS_VIMG); const float* const ssq_kv = (const float*)(ws + WS_SSQ) + T;
        float ssv[2][4];
#pragma unroll
        for (int ai = 0; ai < 2; ++ai)
#pragma unroll
            for (int m = 0; m < 4; ++m) ssv[ai][m] = ssq_kv[(size_t)ROW_OF(ai, m)];
#pragma unroll
        for (int ai = 0; ai < 2; ++ai)
#pragma unroll
            for (int m = 0; m < 4; ++m) {
                const size_t row = (size_t)ROW_OF(ai, m);
                const float sc = __builtin_amdgcn_rsqf(ssv[ai][m] * (1.0f / KVLORA) + EPS);
                const int b = (int)(row >> 11), s = (int)(row & 2047);
                const f32x4 a0 = acc[ai][0][m][0] * sc, a1 = acc[ai][0][m][1] * sc, b0 = acc[ai][1][m][0] * sc, b1 = acc[ai][1][m][1] * sc;
                if (pn < 4) {
                    const int ks = 2 * wc + (fq >> 1), h = fq & 1;
                    bf16_t* p = KN + ((size_t)((b * 8 + 2 * pn) * 64 + (s >> 5))) * 4096 + (ks * 2 + h) * 256 + (s & 31) * 8;
                    st16(p, pk8(a0, a1)); st16(p + (size_t)64 * 4096, pk8(b0, b1));
                } else {
                    bf16_t* p = VI + ((size_t)((b * 8 + 2 * (pn - 4)) * 256 + (s >> 3))) * 1024 + wc * 256 + (s & 7) * 32 + 8 * fq;
                    st16(p, pk8(a0, a1)); st16(p + (size_t)256 * 1024, pk8(b0, b1));
                }
            }
    }
};

struct EpiMerge {
    static constexpr bool PERM = true, AFTER_DRAIN = false, HAS_MID = true; static constexpr int MID_T = 16;
    unsigned char* ws; float* out;
    __device__ __forceinline__ void mid(AccT& acc, const Unit& u, int wr, int wc, int fr_, int fq_) const {
        int fr = fr_, fq = fq_; asm volatile("" : "+v"(fr), "+v"(fq));
        const bf16_t* const R = (const bf16_t*)out;
        u32x4 w[2][4][2];
#pragma unroll
        for (int ai = 0; ai < 2; ++ai)
#pragma unroll
            for (int m = 0; m < 4; ++m)
#pragma unroll
                for (int bj = 0; bj < 2; ++bj) w[ai][m][bj] = __builtin_nontemporal_load((const u32x4*)(R + (size_t)ROW_OF(ai, m) * 1024 + u.pn * 256 + bj * 128 + wc * 32 + 8 * fq));
#pragma unroll
        for (int ai = 0; ai < 2; ++ai)
#pragma unroll
            for (int m = 0; m < 4; ++m)
#pragma unroll
                for (int bj = 0; bj < 2; ++bj) { const u32x4 v = w[ai][m][bj];
                    acc[ai][bj][m][0] *= (f32x4){bf_lo(v.x), bf_hi(v.x), bf_lo(v.y), bf_hi(v.y)};
                    acc[ai][bj][m][1] *= (f32x4){bf_lo(v.z), bf_hi(v.z), bf_lo(v.w), bf_hi(v.w)}; }
        asm volatile("" ::: "memory");
    }
    __device__ __forceinline__ void operator()(const AccT& acc, const Unit& u, int wr, int wc, int fr_, int fq_) const {
        int fr = fr_, fq = fq_; asm volatile("" : "+v"(fr), "+v"(fq));
        const bf16_t* const SB = (const bf16_t*)out + (size_t)T * 1024; bf16_t* const M = (bf16_t*)(ws + WS_RA);
        u32x4 w[2][4][2];
#pragma unroll
        for (int ai = 0; ai < 2; ++ai)
#pragma unroll
            for (int m = 0; m < 4; ++m)
#pragma unroll
                for (int bj = 0; bj < 2; ++bj) w[ai][m][bj] = __builtin_nontemporal_load((const u32x4*)(SB + (size_t)ROW_OF(ai, m) * 1024 + u.pn * 256 + bj * 128 + wc * 32 + 8 * fq));
#pragma unroll
        for (int ai = 0; ai < 2; ++ai)
#pragma unroll
            for (int m = 0; m < 4; ++m)
#pragma unroll
                for (int bj = 0; bj < 2; ++bj) { const u32x4 v = w[ai][m][bj];
                    const size_t off = (size_t)ROW_OF(ai, m) * 1024 + u.pn * 256 + bj * 128 + wc * 32 + 8 * fq;
                    const f32x4 v0 = acc[ai][bj][m][0] * (f32x4){bf_lo(v.x), bf_hi(v.x), bf_lo(v.y), bf_hi(v.y)};
                    const f32x4 v1 = acc[ai][bj][m][1] * (f32x4){bf_lo(v.z), bf_hi(v.z), bf_lo(v.w), bf_hi(v.w)};
                    st16c(M + off, pk8(v0, v1)); }
    }
};

struct EpiOut {
    static constexpr bool PERM = true, AFTER_DRAIN = false, HAS_MID = false; static constexpr int MID_T = 0;
    unsigned char* ws;
    __device__ __forceinline__ void mid(AccT&, const Unit&, int, int, int, int) const {}
    __device__ __forceinline__ void operator()(const AccT& acc, const Unit& u, int wr, int wc, int fr_, int fq_) const {
        int fr = fr_, fq = fq_; asm volatile("" : "+v"(fr), "+v"(fq));
#pragma unroll
        for (int ai = 0; ai < 2; ++ai)
#pragma unroll
            for (int m = 0; m < 4; ++m) {
                const size_t row = (size_t)ROW_OF(ai, m);
                bf16_t* const O = (bf16_t*)(ws + WS_RB); float* const ssq_o = (float*)(ws + WS_SSQ) + 2 * T;
                float s = 0.f;
#pragma unroll
                for (int bj = 0; bj < 2; ++bj) {
                    const f32x4 v0 = acc[ai][bj][m][0], v1 = acc[ai][bj][m][1];
                    s += sumsq4(v0) + sumsq4(v1);
                    st16c(O + row * 1024 + u.pn * 256 + bj * 128 + wc * 32 + 8 * fq, pk8(v0, v1));
                }
                s += __shfl_xor(s, 16); s += __shfl_xor(s, 32);
                if (fq == 0) atomicAdd(ssq_o + row, s);
            }
    }
};

__device__ __forceinline__ float wave_sum(float v) {
#pragma unroll
    for (int o = 1; o < 64; o <<= 1) v += __shfl_xor(v, o);
    return v;
}
__device__ __forceinline__ void transpose_item(const float* W, int ldw, int k0, int srcn0, bf16_t* WT, int ldk, int dstrow0, int dstk0, const float* ksc, LAS float* scr, int lane) {
    float tv[32];
#pragma unroll
    for (int i = 0; i < 32; ++i) { const int kk = 2 * i + (lane >> 5); tv[i] = 0.f;
        if (srcn0 >= 0) { tv[i] = __builtin_nontemporal_load(W + (size_t)(k0 + kk) * ldw + srcn0 + (lane & 31)); } }
#pragma unroll
    for (int i = 0; i < 32; ++i) { const int kk = 2 * i + (lane >> 5); float v = tv[i]; if (srcn0 >= 0 && ksc) v *= ksc[k0 + kk];
        scr[kk * 33 + (lane & 31)] = v; }
    asm volatile("s_waitcnt lgkmcnt(0)" ::: "memory");
    const int c = lane & 7;
#pragma unroll
    for (int j = 0; j < 4; ++j) { const int n = (lane >> 3) + 8 * j; const LAS float* s = scr + (8 * c) * 33 + n;
        u32x4 o; o.x = pk2(s[0 * 33], s[1 * 33]); o.y = pk2(s[2 * 33], s[3 * 33]); o.z = pk2(s[4 * 33], s[5 * 33]); o.w = pk2(s[6 * 33], s[7 * 33]);
        *(u32x4*)(WT + (size_t)(dstrow0 + n) * ldk + dstk0 + 8 * c) = o; }
    asm volatile("s_waitcnt lgkmcnt(0)" ::: "memory");
}
__device__ __forceinline__ int win_src(int vg) {
    const int tnew = vg >> 3, tile = tnew < 8 ? tnew : (tnew < 23 ? tnew + 8 : tnew - 15), half = (vg >> 2) & 1, wc = vg & 3;
    if (tile < 8) return (half ? 2048 : 0) + 128 * tile + 32 * wc;
    if (tile < 16) return (half ? 3072 : 1024) + 128 * (tile - 8) + 32 * wc;
    if (tile == 16) return 4096 + 32 * (vg & 7);
    if (tile == 17) return half ? 4480 + 32 * wc : 4352 + 32 * wc;
    if (tile == 18) return wc < 2 ? 4608 + 64 * half + 32 * wc : (wc == 2 ? 4736 + 32 * half : -1);
    if (tile < 23) return 4800 + 256 * (tile - 19) + 32 * (vg & 7);
    return (half ? 6848 : 5824) + 128 * (tile - 23) + 32 * wc;
}
__device__ __forceinline__ int wuq_src(int vg) {
    const int tile = vg >> 3;
    if (tile < 4) { const int col = vg * 32; return (col >> 7) * 192 + (col & 127); }
    const int half = (vg >> 2) & 1, wc = vg & 3; return (4 * (tile - 4) + wc) * 192 + 128 + 32 * half;
}
__device__ __forceinline__ int wukv_src(int vg) {
    const int col = vg * 32;
    if (col < 1024) return (col >> 7) * 256 + (col & 127);
    const int c2 = col - 1024; return (c2 >> 7) * 256 + 128 + (c2 & 127);
}

struct Ptrs {
    const float *x, *c, *w_ada, *b_ada, *g_pre, *w_in, *conv_w, *w_conv_out, *g_q, *w_uq, *g_kv, *w_ukv, *w_mla_out, *w_out, *g_post; const int* positions;
    float* out; unsigned char* ws;
};

__device__ __forceinline__ void phase0(const Ptrs& P, LAS unsigned char* lds, int G) {
    const int tid = threadIdx.x, lane = tid & 63, wave = __builtin_amdgcn_readfirstlane(tid >> 6);
    const int gt = blockIdx.x * 512 + tid, NGT = G * 512;
    if (blockIdx.x < 96) { LAS float* cl = (LAS float*)lds; LAS float* red = (LAS float*)(lds + 65536); float* mod = (float*)(P.ws + WS_MOD);
      for (int i = tid; i < 16384; i += 512) cl[i] = P.c[i];
      __syncthreads();
      for (int item = blockIdx.x; item < 96; item += G) {
          const int n0 = item * 32, kh = lane >> 5, col = lane & 31; float acc[16];
#pragma unroll
          for (int b = 0; b < 16; ++b) acc[b] = 0.f;
#pragma unroll 8
          for (int it = 0; it < 64; ++it) { const int k = wave * 128 + 2 * it + kh; const float wv = __builtin_nontemporal_load(P.w_ada + (size_t)k * 3072 + n0 + col);
#pragma unroll
              for (int b = 0; b < 16; ++b) acc[b] += cl[b * 1024 + k] * wv; }
#pragma unroll
          for (int b = 0; b < 16; ++b) { acc[b] += __shfl_xor(acc[b], 32); if (lane < 32) red[(wave * 16 + b) * 32 + col] = acc[b]; }
          __syncthreads();
          { const int b = tid >> 5, c2 = tid & 31; float sm = P.b_ada[n0 + c2];
#pragma unroll
            for (int w = 0; w < 8; ++w) sm += red[(w * 16 + b) * 32 + c2];
            mod[b * 3072 + n0 + c2] = sm; }
          __syncthreads();
      } }
    if (blockIdx.x < 96) {
        asm volatile("s_waitcnt vmcnt(0)" ::: "memory"); __syncthreads();
        if (tid == 0) { __builtin_amdgcn_fence(__ATOMIC_RELEASE, "agent"); asm volatile("s_waitcnt vmcnt(0)" ::: "memory");
            __hip_atomic_fetch_add((unsigned*)(P.ws + WS_BAR) + 3520, 1u, __ATOMIC_RELAXED, __HIP_MEMORY_SCOPE_AGENT); }
    }
    float* ssq = (float*)(P.ws + WS_SSQ);
    for (int i = gt; i < 3 * T; i += NGT) ssq[i] = 0.f;
    { float* rope = (float*)(P.ws + WS_ROPE);
      for (int i = gt; i < T * 32; i += NGT) { const int row = i >> 5, j = i & 31;
          const float inv = exp2f(-(float)j * (13.287712379549449f / 32.0f));
          const float ang = (float)P.positions[row] * inv;
          const double rev = (double)ang * 0.15915494309189535; const float fr = (float)(rev - rint(rev));
          float sn, cs; { const float a = fr * 6.283185307179586f; sn = __sinf(a); cs = __cosf(a); }
          *(f32x2_t*)(rope + (size_t)i * 2) = (f32x2_t){cs, sn}; } }
    __syncthreads();
    { LAS float* scr = (LAS float*)(lds + wave * 16384);
      const int first = G > 128 ? 96 : 0;
      const int gw = ((int)blockIdx.x - first) * 8 + wave, NGW = (G - first) * 8;
      bf16_t* WIN = (bf16_t*)(P.ws + WS_WIN); bf16_t* WM = (bf16_t*)(P.ws + WS_WM); bf16_t* WUQ = (bf16_t*)(P.ws + WS_WUQ); bf16_t* WUKV = (bf16_t*)(P.ws + WS_WUKV); bf16_t* WOUT = (bf16_t*)(P.ws + WS_WOUT);
      constexpr int I_IN = 16 * 248, I_M = 32 * 32, I_UQ = 6 * 48, I_UKV = 4 * 64, I_OUT = 16 * 32, NITEMS = I_IN + I_M + I_UQ + I_UKV + I_OUT;
      if ((int)blockIdx.x >= first)
      for (int it = gw; it < NITEMS; it += NGW) {
          int r = it;
          if (r < I_IN) { const int kb = r / 248, vg = r % 248; transpose_item(P.w_in, NIN, kb * 64, win_src(vg), WIN, 1024, vg * 32, kb * 64, nullptr, scr, lane); continue; } r -= I_IN;
          if (r < I_M) { const int kb = r >> 5, nb = r & 31; if (kb < 16) transpose_item(P.w_conv_out, 1024, kb * 64, nb * 32, WM, 2048, nb * 32, kb * 64, nullptr, scr, lane);
                         else transpose_item(P.w_mla_out, 1024, (kb - 16) * 64, nb * 32, WM, 2048, nb * 32, kb * 64, nullptr, scr, lane); continue; } r -= I_M;
          if (r < I_UQ) { const int kb = r / 48, vg = r % 48; transpose_item(P.w_uq, 1536, kb * 64, wuq_src(vg), WUQ, QLORA, vg * 32, kb * 64, P.g_q, scr, lane); continue; } r -= I_UQ;
          if (r < I_UKV) { const int kb = r >> 6, vg = r & 63; transpose_item(P.w_ukv, 2048, kb * 64, wukv_src(vg), WUKV, KVLORA, vg * 32, kb * 64, P.g_kv, scr, lane); continue; } r -= I_UKV;
          { const int kb = r >> 5, nb = r & 31; transpose_item(P.w_out, 1024, kb * 64, nb * 32, WOUT, 1024, nb * 32, kb * 64, nullptr, scr, lane); }
      } }
}

__device__ __forceinline__ void phase1(const Ptrs& P, int G) {
    const int tid = threadIdx.x, lane = tid & 63, wave = tid >> 6;
    const int gw = blockIdx.x * 8 + wave, NGW = G * 8;
    const float* mod = (const float*)(P.ws + WS_MOD); bf16_t* H = (bf16_t*)(P.ws + WS_H);
    if (tid == 0) {
        unsigned* cnt = (unsigned*)(P.ws + WS_BAR) + 3520; const unsigned want = G < 96 ? (unsigned)G : 96u; unsigned sp = 0;
        while (__hip_atomic_load(cnt, __ATOMIC_RELAXED, __HIP_MEMORY_SCOPE_AGENT) < want) { __builtin_amdgcn_s_sleep(2); if (++sp > (1u << 22)) break; }
        __builtin_amdgcn_fence(__ATOMIC_ACQUIRE, "agent"); asm volatile("s_waitcnt vmcnt(0)" ::: "memory");
    }
    __syncthreads();
    for (int row0 = gw; row0 < T; row0 += 2 * NGW) {
        f32x4 v[2][4]; float s[2] = {0.f, 0.f};
#pragma unroll
        for (int r = 0; r < 2; ++r) { const int row = row0 + r * NGW; if (row < T) { const f32x4* xr = (const f32x4*)(P.x + (size_t)row * DM) + lane;
#pragma unroll
            for (int j = 0; j < 4; ++j) v[r][j] = __builtin_nontemporal_load(xr + 64 * j); } }
#pragma unroll
        for (int r = 0; r < 2; ++r) { const int row = row0 + r * NGW; if (row < T) {
#pragma unroll
            for (int j = 0; j < 4; ++j) s[r] += sumsq4(v[r][j]);
            const int b = row >> 11;
            const float rstd = __builtin_amdgcn_rsqf(wave_sum(s[r]) * (1.0f / DM) + EPS);
            u32x2* o8 = (u32x2*)(H + (size_t)row * DM) + lane;
#pragma unroll
            for (int j = 0; j < 4; ++j) {
                const int col = 256 * j + 4 * lane;
                const f32x4 g = *(const f32x4*)(P.g_pre + col), sh = *(const f32x4*)(mod + b * 3072 + col), sc = *(const f32x4*)(mod + b * 3072 + 1024 + col);
                const f32x4 h = v[r][j] * rstd * g * (sc + 1.0f) + sh;
                u32x2 w; w.x = pk2(h[0], h[1]); w.y = pk2(h[2], h[3]); o8[64 * j] = w;
            } } }
    }
}

__device__ __forceinline__ void conv_pass(const Ptrs& P, int G) {
    const int gt = blockIdx.x * 512 + threadIdx.x, NGT = G * 512;
    const bf16_t* U = (const bf16_t*)(P.ws + WS_RB); bf16_t* A2 = (bf16_t*)(P.ws + WS_A2);
    for (int i = gt; i < T * 128; i += NGT) {
        const int row = i >> 7, c0 = (i & 127) * 8, s = row & 2047;
        const u32x4 z4 = {0u, 0u, 0u, 0u};
        const u32x4 u2 = *(const u32x4*)(U + (size_t)row * 1024 + c0);
        const u32x4 u1 = s >= 1 ? *(const u32x4*)(U + (size_t)(row - 1) * 1024 + c0) : z4;
        const u32x4 u0 = s >= 2 ? *(const u32x4*)(U + (size_t)(row - 2) * 1024 + c0) : z4;
        const u32x4 gz = *(const u32x4*)(A2 + (size_t)row * 2048 + c0);
        const f32x4 w0a = *(const f32x4*)(P.conv_w + c0), w0b = *(const f32x4*)(P.conv_w + c0 + 4);
        const f32x4 w1a = *(const f32x4*)(P.conv_w + 1024 + c0), w1b = *(const f32x4*)(P.conv_w + 1024 + c0 + 4);
        const f32x4 w2a = *(const f32x4*)(P.conv_w + 2048 + c0), w2b = *(const f32x4*)(P.conv_w + 2048 + c0 + 4);
        f32x4 ya, yb;
#define CV(W, k) (k == 0 ? bf_lo(W.x) : k == 1 ? bf_hi(W.x) : k == 2 ? bf_lo(W.y) : k == 3 ? bf_hi(W.y) : k == 4 ? bf_lo(W.z) : k == 5 ? bf_hi(W.z) : k == 6 ? bf_lo(W.w) : bf_hi(W.w))
#pragma unroll
        for (int k = 0; k < 4; ++k) {
            ya[k] = CV(gz, k) * (w0a[k] * CV(u0, k) + w1a[k] * CV(u1, k) + w2a[k] * CV(u2, k));
            yb[k] = CV(gz, (k + 4)) * (w0b[k] * CV(u0, (k + 4)) + w1b[k] * CV(u1, (k + 4)) + w2b[k] * CV(u2, (k + 4)));
        }
#undef CV
        *(u32x4*)(A2 + (size_t)row * 2048 + c0) = pk8(ya, yb);
    }
}

__device__ __forceinline__ void final_pass(const Ptrs& P, int G) {
    const int gt = blockIdx.x * 512 + threadIdx.x, NGT = G * 512;
    const bf16_t* O = (const bf16_t*)(P.ws + WS_RB); const float* ssq_o = (const float*)(P.ws + WS_SSQ) + 2 * T; const float* mod = (const float*)(P.ws + WS_MOD);
    for (int i0 = gt; i0 < T * 128; i0 += 4 * NGT) {
        u32x4 o[4]; f32x4 xa[4], xb[4]; float sq[4];
#pragma unroll
        for (int j = 0; j < 4; ++j) { const int i = i0 + j * NGT; if (i < T * 128) { const int row = i >> 7, c0 = (i & 127) * 8;
            o[j] = *(const u32x4*)(O + (size_t)row * 1024 + c0); xa[j] = *(const f32x4*)(P.x + (size_t)row * DM + c0); xb[j] = *(const f32x4*)(P.x + (size_t)row * DM + c0 + 4); sq[j] = ssq_o[row]; } }
#pragma unroll
        for (int j = 0; j < 4; ++j) { const int i = i0 + j * NGT; if (i < T * 128) { const int row = i >> 7, c0 = (i & 127) * 8, b = row >> 11;
            const float rstd = __builtin_amdgcn_rsqf(sq[j] * (1.0f / DM) + EPS);
            const f32x4 ga = *(const f32x4*)(mod + b * 3072 + 2048 + c0) * *(const f32x4*)(P.g_post + c0), gb = *(const f32x4*)(mod + b * 3072 + 2048 + c0 + 4) * *(const f32x4*)(P.g_post + c0 + 4);
            const f32x4 oa = {bf_lo(o[j].x), bf_hi(o[j].x), bf_lo(o[j].y), bf_hi(o[j].y)}, ob = {bf_lo(o[j].z), bf_hi(o[j].z), bf_lo(o[j].w), bf_hi(o[j].w)};
            __builtin_nontemporal_store(xa[j] + ga * oa * rstd, (f32x4*)(P.out + (size_t)row * DM + c0));
            __builtin_nontemporal_store(xb[j] + gb * ob * rstd, (f32x4*)(P.out + (size_t)row * DM + c0 + 4)); } }
    }
}

constexpr int ATT_STAGE = 40960;
__device__ __forceinline__ bf16x8 lds_rd16(LAS const unsigned char* p) { return *(LAS const bf16x8*)p; }
__device__ __forceinline__ float max3f_(float a, float b, float c) { float r; asm("v_max3_f32 %0, %1, %2, %3" : "=v"(r) : "v"(a), "v"(b), "v"(c)); return r; }
__device__ __forceinline__ v4i16_t lds_tr(LAS const unsigned char* p) { return __builtin_amdgcn_ds_read_tr16_b64_v4i16((LAS v4i16_t*)p); }

__device__ __forceinline__ void attn_phase(const Ptrs& P, LAS unsigned char* lds, int vcu) {
    const int tid = threadIdx.x, lane = tid & 63, wid = __builtin_amdgcn_readfirstlane(tid >> 6), r32 = lane & 31, hi = lane >> 5;
    const bf16_t* QI = (const bf16_t*)(P.ws + WS_QIMG); const bf16_t* KN = (const bf16_t*)(P.ws + WS_RA); const bf16_t* KPE = (const bf16_t*)(P.ws + WS_KPE); const bf16_t* VI = (const bf16_t*)(P.ws + WS_VIMG);
    bf16_t* A2 = (bf16_t*)(P.ws + WS_A2);
    const int bh = vcu >> 1, b = bh >> 3, head = bh & 7;
    const bf16_t* kn_b = KN + (size_t)bh * 64 * 4096 + lane * 8; const bf16_t* kpe_b = KPE + (size_t)b * 64 * 2048 + lane * 8; const bf16_t* v_b = VI + (size_t)bh * 256 * 1024 + lane * 8;
    LAS unsigned char* const wz = lds + 2 * ATT_STAGE + wid * 8192;
    const int vb = 24576 + (4 * hi + ((lane & 15) >> 2)) * 64 + ((lane >> 4) & 1) * 32 + (lane & 3) * 8;
#define ISSUE_TILE(t, st) do { _Pragma("unroll") for (int i_ = 0; i_ < 5; ++i_) { const int c_ = wid * 5 + i_; \
        const bf16_t* g_ = c_ < 16 ? kn_b + (size_t)(t) * 8192 + c_ * 512 : (c_ < 24 ? kpe_b + (size_t)(t) * 4096 + (c_ - 16) * 512 : v_b + (size_t)(t) * 8192 + (c_ - 24) * 512); \
        __builtin_amdgcn_global_load_lds((const unsigned*)g_, (LAS unsigned*)(lds + (st) * ATT_STAGE + c_ * 1024), 16, 0, 0); } } while (0)
#define QB_OF(ui) ((vcu & 1) ? ((ui) == 0 ? 5 : (ui) == 1 ? 2 : (ui) == 2 ? 4 : 3) : ((ui) == 0 ? 7 : (ui) == 1 ? 0 : (ui) == 2 ? 6 : 1))
#define LOAD_QF(qw_) do { const bf16_t* qp = QI + ((size_t)(bh * 64 + ((qw_) >> 5))) * 6144 + lane * 8; \
        _Pragma("unroll") for (int ks = 0; ks < 12; ++ks) qf[ks] = *(const bf16x8*)(qp + ks * 512); } while (0)
    bf16x8 qf[12];
    ISSUE_TILE(0, 0);
    LOAD_QF(QB_OF(0) * 256 + 32 * wid);
    for (int ui = 0; ui < 4; ++ui) {
        const int qb = QB_OF(ui);
        const int q0 = qb * 256, NT = 4 * (qb + 1), qw = q0 + 32 * wid;
        { const bf16_t* zsrc = A2 + (size_t)(b * SEQ + qw) * 2048 + 1024 + head * 128;
          int lp = lane; asm volatile("" : "+v"(lp));
#pragma unroll
          for (int c = 0; c < 8; ++c) { const int r = c * 4 + (lp >> 4), k = (lp & 15) ^ (r & 15);
              __builtin_amdgcn_global_load_lds((const unsigned*)(zsrc + (size_t)r * 2048 + k * 8), (LAS unsigned*)(wz + c * 1024), 16, 0, 0); } }
        f32x16 o[4];
#pragma unroll
        for (int d = 0; d < 4; ++d)
#pragma unroll
            for (int i = 0; i < 16; ++i) o[d][i] = 0.f;
        float mrun = 0.f, lrun = 0.f; f32x16 negmv;
#pragma unroll
        for (int i = 0; i < 16; ++i) negmv[i] = 0.f;
        for (int t = 0; t < NT; ++t) {
            asm volatile("s_waitcnt vmcnt(0)" ::: "memory");
            __syncthreads();
            if (t + 1 < NT) ISSUE_TILE(t + 1, (t + 1) & 1); else if (ui + 1 < 4) ISSUE_TILE(0, 0);
            if (64 * t <= qw) {
                LAS const unsigned char* st = lds + (t & 1) * ATT_STAGE;
                f32x16 p0, p1;
#define KOFF0(ks) ((ks) < 8 ? (ks) * 1024 : 16384 + ((ks) - 8) * 1024)
#define KOFF1(ks) ((ks) < 8 ? (8 + (ks)) * 1024 : 16384 + (4 + (ks) - 8) * 1024)
                { constexpr int PD = 4;
                  bf16x8 ka[12], kb[12];
#pragma unroll
                  for (int ks = 0; ks < PD; ++ks) { ka[ks] = lds_rd16(st + KOFF0(ks) + lane * 16); kb[ks] = lds_rd16(st + KOFF1(ks) + lane * 16); }
                  __builtin_amdgcn_sched_barrier(0);
#pragma unroll
                  for (int ks = 0; ks < 12; ++ks) {
                      if (ks + PD < 12) { ka[ks + PD] = lds_rd16(st + KOFF0(ks + PD) + lane * 16); kb[ks + PD] = lds_rd16(st + KOFF1(ks + PD) + lane * 16); }
                      p0 = __builtin_amdgcn_mfma_f32_32x32x16_bf16(ka[ks], qf[ks], ks == 0 ? negmv : p0, 0, 0, 0);
                      p1 = __builtin_amdgcn_mfma_f32_32x32x16_bf16(kb[ks], qf[ks], ks == 0 ? negmv : p1, 0, 0, 0);
                      __builtin_amdgcn_sched_barrier(0);
                  } }
#undef KOFF0
#undef KOFF1
                if (64 * t + 63 > qw) {
                    const int qa = qw + r32 - 64 * t - 4 * hi;
#pragma unroll
                    for (int i = 0; i < 16; ++i) { const int kv = (i & 3) + 8 * (i >> 2); if (kv > qa) p0[i] = -INFINITY; if (kv + 32 > qa) p1[i] = -INFINITY; }
                }
                float rm = max3f_(p0[0], p1[0], p0[1]);
                rm = max3f_(rm, p1[1], p0[2]);
#pragma unroll
                for (int i = 2; i < 15; ++i) rm = max3f_(rm, p1[i], p0[i + 1]);
                rm = fmaxf(rm, p1[15]);
                { auto rr = __builtin_amdgcn_permlane32_swap(__float_as_uint(rm), __float_as_uint(rm), false, false); rm = fmaxf(__uint_as_float(rr[0]), __uint_as_float(rr[1])); }
                if (t == 0 || __any(rm > 8.0f)) {
                    const float dl = t == 0 ? rm : fmaxf(rm, 0.f), alpha = __builtin_amdgcn_exp2f(-dl);
                    mrun = (t == 0 ? 0.f : mrun) + dl;
#pragma unroll
                    for (int i = 0; i < 16; ++i) { p0[i] -= dl; p1[i] -= dl; negmv[i] = -mrun; }
                    if (t != 0) { lrun *= alpha;
#pragma unroll
                        for (int d = 0; d < 4; ++d)
#pragma unroll
                            for (int i = 0; i < 16; ++i) o[d][i] *= alpha;
                    }
                }
                float ls = 0.f;
#pragma unroll
                for (int s = 0; s < 4; ++s) {
                    float e[8];
#pragma unroll
                    for (int j = 0; j < 8; ++j) { e[j] = __builtin_amdgcn_exp2f(s < 2 ? p0[8 * (s & 1) + j] : p1[8 * (s & 1) + j]); }
                    ls += ((e[0] + e[1]) + (e[2] + e[3])) + ((e[4] + e[5]) + (e[6] + e[7]));
                    u32x4 pw; pw.x = pk2(e[0], e[1]); pw.y = pk2(e[2], e[3]); pw.z = pk2(e[4], e[5]); pw.w = pk2(e[6], e[7]);
                    const bf16x8 pb = __builtin_bit_cast(bf16x8, pw);
#pragma unroll
                    for (int d = 0; d < 4; ++d) {
                        const v4i16_t lo = lds_tr(st + vb + ((2 * s) * 4 + d) * 512), hv = lds_tr(st + vb + ((2 * s + 1) * 4 + d) * 512);
                        const bf16x8 va = {lo[0], lo[1], lo[2], lo[3], hv[0], hv[1], hv[2], hv[3]};
                        o[d] = __builtin_amdgcn_mfma_f32_32x32x16_bf16(va, pb, o[d], 0, 0, 0);
                    }
                }
                lrun += ls;
            }
        }
        { auto rr = __builtin_amdgcn_permlane32_swap(__float_as_uint(lrun), __float_as_uint(lrun), false, false); lrun = __uint_as_float(rr[0]) + __uint_as_float(rr[1]); }
        if (ui + 1 < 4) LOAD_QF(QB_OF(ui + 1) * 256 + 32 * wid);
        const float inv = 1.0f / lrun;
        int rq = r32; asm volatile("" : "+v"(rq));
#pragma unroll
        for (int d = 0; d < 4; ++d)
#pragma unroll
            for (int g = 0; g < 4; ++g) {
                LAS u32x2* zp = (LAS u32x2*)(wz + (rq * 16 + ((4 * d + g) ^ (rq & 15))) * 16 + 8 * hi);
                const u32x2 z = *zp;
                u32x2 w; w.x = pk2(o[d][4 * g] * inv * bf_lo(z.x), o[d][4 * g + 1] * inv * bf_hi(z.x)); w.y = pk2(o[d][4 * g + 2] * inv * bf_lo(z.y), o[d][4 * g + 3] * inv * bf_hi(z.y));
                *zp = w;
            }
        { bf16_t* obase = A2 + (size_t)(b * SEQ + qw) * 2048 + 1024 + head * 128;
          int ln = lane; asm volatile("" : "+v"(ln));
#pragma unroll
          for (int i = 0; i < 8; ++i) { const int r = i * 4 + (ln >> 4), k = (ln & 15) ^ (r & 15);
              const u32x4 v = *(LAS const u32x4*)(wz + (i * 64 + ln) * 16);
              *(u32x4*)(obase + (size_t)r * 2048 + k * 8) = v; } }
    }
#undef ISSUE_TILE
#undef QB_OF
#undef LOAD_QF
    asm volatile("s_waitcnt vmcnt(0)" ::: "memory");
    __syncthreads();
}

#define XB_TMO      128
#define XB_XCNT(j)  (256  + 64 * (j))
#define XB_XSUB(j)  (1280 + 64 * (j))
#define XB_XGEN(j)  (2304 + 64 * (j))
#define XB_TOP      3328
#define XB_TOPGEN   3392
#define XCD_BAR_WORDS 3456
#define XB_SPIN_CAP (1u << 18)

__device__ __forceinline__ unsigned xb_ld(unsigned* p)              { return __hip_atomic_load(p, __ATOMIC_RELAXED, __HIP_MEMORY_SCOPE_AGENT); }
__device__ __forceinline__ unsigned xb_add(unsigned* p, unsigned v) { return __hip_atomic_fetch_add(p, v, __ATOMIC_RELAXED, __HIP_MEMORY_SCOPE_AGENT); }
__device__ __forceinline__ unsigned xb_xcc_id() { return (unsigned)__builtin_amdgcn_s_getreg((3 << 11) | 20) & 0xFu; }
#define XB_SPIN(cond, bar) do { unsigned _sp = 0; while (cond) { __builtin_amdgcn_s_sleep(1); \
    if ((++_sp & 255u) == 0u) { if (xb_ld(&(bar)[XB_TMO])) break; if (_sp > XB_SPIN_CAP) { atomicAdd(&(bar)[XB_TMO], 1u); break; } } } } while (0)

struct XcdBarrier {
    unsigned* bar; unsigned x;
    volatile LAS unsigned* st;
};

__device__ __forceinline__ XcdBarrier xcd_barrier_post(unsigned* bar, volatile LAS unsigned* st) {
    XcdBarrier b; b.bar = bar; b.x = xb_xcc_id(); b.st = st;
    if (threadIdx.x == 0) (void)xb_add(&bar[XB_XCNT(b.x)], 1u);
    return b;
}
__device__ __forceinline__ void xcd_barrier_complete(unsigned* bar, unsigned x, unsigned& nloc, unsigned& nx) {
    const unsigned G = gridDim.x * gridDim.y * gridDim.z;
    unsigned sum, cnt, mine, sp = 0u;
    for (;;) {
        sum = 0u; cnt = 0u; mine = 0u;
#pragma unroll
        for (unsigned j = 0; j < 16; ++j) { const unsigned c = xb_ld(&bar[XB_XCNT(j)]); sum += c; cnt += (c > 0u) ? 1u : 0u; mine = (j == x) ? c : mine; }
        if (sum == G) break;
        __builtin_amdgcn_s_sleep(1);
        if ((++sp & 255u) == 0u) { if (xb_ld(&bar[XB_TMO])) break; if (sp > XB_SPIN_CAP) { atomicAdd(&bar[XB_TMO], 1u); break; } }
    }
    nloc = mine > 0u ? mine : 1u; nx = cnt > 0u ? cnt : 1u;
}

__device__ __forceinline__ void xcd_barrier(const XcdBarrier& b) {
    asm volatile("s_waitcnt vmcnt(0)" ::: "memory");
    __syncthreads();
    if (threadIdx.x == 0) {
        unsigned* bar = b.bar;
        __builtin_amdgcn_s_waitcnt(0);
        unsigned nloc = b.st[0], nx = b.st[1];
        if (nloc == 0u) { xcd_barrier_complete(bar, b.x, nloc, nx); b.st[0] = nloc; b.st[1] = nx; }
        const unsigned old = xb_add(&bar[XB_XSUB(b.x)], 1u);
        const unsigned gen = old / nloc;
        if (old + 1u == (gen + 1u) * nloc) {
            __builtin_amdgcn_fence(__ATOMIC_RELEASE, "agent");
            asm volatile("s_waitcnt vmcnt(0)" ::: "memory");
            const unsigned og = xb_add(&bar[XB_TOP], 1u);
            const unsigned tg = og / nx;
            if (og + 1u == (tg + 1u) * nx) xb_add(&bar[XB_TOPGEN], 1u);
            else XB_SPIN(xb_ld(&bar[XB_TOPGEN]) == tg, bar);
            __builtin_amdgcn_fence(__ATOMIC_ACQUIRE, "agent");
            xb_add(&bar[XB_XGEN(b.x)], 1u);
            asm volatile("s_waitcnt vmcnt(0)" ::: "memory");
        } else {
            XB_SPIN(xb_ld(&bar[XB_XGEN(b.x)]) == gen, bar);
            __builtin_amdgcn_fence(__ATOMIC_ACQUIRE, "agent");
            asm volatile("s_waitcnt vmcnt(0)" ::: "memory");
        }
    }
    __syncthreads();
}

struct Args { const float* in[16]; float* out; unsigned char* ws; int ph_lo, ph_hi; };
constexpr int NPHASE = 8;
#ifndef MK_LAUNCHES
#define MK_LAUNCHES 1
#endif

__global__ void __launch_bounds__(512, 2) fwd_kernel(Args a) {
    extern __shared__ __attribute__((aligned(16))) unsigned char lds_raw[];
    LAS unsigned char* lds = (LAS unsigned char*)lds_raw;
    const int G = gridDim.x, bx = blockIdx.x;
    const int vcu = (G % 8 == 0) ? (bx % 8) * (G / 8) + bx / 8 : bx;
    Ptrs P;
    P.x = a.in[0]; P.c = a.in[1]; P.positions = (const int*)a.in[2]; P.w_ada = a.in[3]; P.b_ada = a.in[4]; P.g_pre = a.in[5]; P.w_in = a.in[6]; P.conv_w = a.in[7]; P.w_conv_out = a.in[8];
    P.g_q = a.in[9]; P.w_uq = a.in[10]; P.g_kv = a.in[11]; P.w_ukv = a.in[12]; P.w_mla_out = a.in[13]; P.w_out = a.in[14]; P.g_post = a.in[15]; P.out = a.out; P.ws = a.ws;
    const int lo = a.ph_lo, hi = a.ph_hi; (void)lo; (void)hi;
    volatile LAS unsigned* bst = (volatile LAS unsigned*)(lds + 147456 + 64);
    if (threadIdx.x < 2) bst[threadIdx.x] = 0u;
    __syncthreads();
    XcdBarrier bar = xcd_barrier_post((unsigned*)(P.ws + WS_BAR), bst);
    if (a.ph_hi > NPHASE) cg::this_grid().sync();
#ifndef PHMASK
#define PHMASK 0xff
#endif
#define IN(k) (((PHMASK >> (k)) & 1) && lo <= (k) && (k) < hi)
#define SEAM(k) do { if (IN(k) && IN((k) + 1)) { xcd_barrier(bar); } } while (0)
    float* ssq = (float*)(P.ws + WS_SSQ);
    const float* rope = (const float*)(P.ws + WS_ROPE);
    if (IN(0)) { phase0(P, lds, G); }
    if (IN(1)) { phase1(P, G); } SEAM(1);
    if (IN(2)) {
        { pg8::Gemm g{(const bf16_t*)(P.ws + WS_H), (const bf16_t*)(P.ws + WS_WIN), T, 5888, DM}; pg8::StaticOrder S; S.init(T, 5888, G, bx);
          EpiInProj E{P.ws, P.out};
          pg8::gemm_phase<EpiInProj, pg8::StaticOrder, true, true>(lds, g, S, E); }
        xcd_barrier(bar);
        const int flip = (bx >> 3) & 1;
#define RUN_CONV() do { pg8::Gemm g{(const bf16_t*)(P.ws + WS_H), (const bf16_t*)(P.ws + WS_WIN) + (size_t)5888 * DM, T, 2048, DM}; pg8::StaticOrder S; S.init(T, 2048, G, bx); \
            EpiConv E{P.ws, P.conv_w}; pg8::gemm_phase<EpiConv, pg8::StaticOrder, true, true>(lds, g, S, E); } while (0)
#define RUN_KVUP() do { pg8::Gemm g{(const bf16_t*)(P.ws + WS_KVL), (const bf16_t*)(P.ws + WS_WUKV), T, 2048, KVLORA}; pg8::StaticOrder S; S.init(T, 2048, G, bx); \
            EpiKVUp E{P.ws}; pg8::gemm_phase<EpiKVUp, pg8::StaticOrder, true, true>(lds, g, S, E); } while (0)
        if (flip) { RUN_KVUP(); RUN_CONV(); } else { RUN_CONV(); RUN_KVUP(); }
#undef RUN_CONV
#undef RUN_KVUP
        xcd_barrier(bar);
        { pg8::Gemm g{(const bf16_t*)(P.ws + WS_QL), (const bf16_t*)(P.ws + WS_WUQ), T, 1536, QLORA}; pg8::StaticOrder S; S.init(T, 1536, G, bx);
          EpiQUp E{P.ws};
          pg8::gemm_phase<EpiQUp, pg8::StaticOrder, true, true>(lds, g, S, E); }
    } SEAM(3);
    if (IN(4)) { for (int v = vcu; v < 256; v += G) attn_phase(P, lds, v); } SEAM(4);
    if (IN(5)) {
        pg8::Gemm g{(const bf16_t*)(P.ws + WS_A2), (const bf16_t*)(P.ws + WS_WM), T, DM, 2048}; pg8::StaticOrder S; S.init(T, DM, G, bx);
        EpiMerge E{P.ws, P.out};
        pg8::gemm_phase<EpiMerge, pg8::StaticOrder, true, true>(lds, g, S, E);
    } SEAM(5);
    if (IN(6)) {
        pg8::Gemm g{(const bf16_t*)(P.ws + WS_RA), (const bf16_t*)(P.ws + WS_WOUT), T, DM, DM}; pg8::StaticOrder S; S.init(T, DM, G, bx);
        EpiOut E{P.ws};
        pg8::gemm_phase<EpiOut, pg8::StaticOrder, true, true>(lds, g, S, E);
    } SEAM(6);
    if (IN(7)) { final_pass(P, G); }
#undef IN
#undef SEAM
}

extern "C" void kernel_launch(void* const* d_in, const int* in_sizes, int n_in, void* d_out, int out_size, void* d_ws, size_t ws_size, hipStream_t stream) {
    static int grid = 0;
    if (grid == 0) {
        if (n_in != 16 || in_sizes[0] != T * DM || out_size != T * DM || ws_size < WS_END) { fprintf(stderr, "kernel_launch: unexpected shapes: n_in %d in0 %d out %d ws %zu (need %zu)\n", n_in, n_in > 0 ? in_sizes[0] : -1, out_size, ws_size, (size_t)WS_END); grid = -1; return; }
        int dev = 0, cus = 0, per_cu = 0;
        hipGetDevice(&dev); hipDeviceGetAttribute(&cus, hipDeviceAttributeMultiprocessorCount, dev);
        if (hipFuncSetAttribute((const void*)fwd_kernel, hipFuncAttributeMaxDynamicSharedMemorySize, LDS_BYTES) != hipSuccess) { fprintf(stderr, "kernel_launch: hipFuncSetAttribute failed\n"); grid = -1; return; }
        if (hipOccupancyMaxActiveBlocksPerMultiprocessor(&per_cu, (const void*)fwd_kernel, 512, LDS_BYTES) != hipSuccess || per_cu < 1) { fprintf(stderr, "kernel_launch: occupancy query says %d\n", per_cu); per_cu = 1; }
        (void)hipGetLastError();
        grid = cus * 1;
        if (grid <= 0) grid = 256;
    }
    if (grid < 0) return;
    if (hipMemsetAsync((char*)d_ws + WS_BAR, 0, 16384, stream) != hipSuccess) { fprintf(stderr, "kernel_launch: memset failed\n"); return; }
    Args a{};
    for (int i = 0; i < 16; ++i) a.in[i] = (const float*)d_in[i];
    a.out = (float*)d_out; a.ws = (unsigned char*)d_ws;
#if MK_LAUNCHES == 1
    a.ph_lo = 0; a.ph_hi = NPHASE;
    void* args[] = {&a};
    hipError_t e = hipLaunchCooperativeKernel((const void*)fwd_kernel, dim3(grid), dim3(512), args, LDS_BYTES, stream);
    if (e != hipSuccess) fprintf(stderr, "cooperative launch failed: %s (grid %d)\n", hipGetErrorString(e), grid);
#else
    for (int p = 0; p < NPHASE; ++p) { a.ph_lo = p; a.ph_hi = p + 1; hipLaunchKernelGGL(fwd_kernel, dim3(grid), dim3(512), LDS_BYTES, stream, a); }
#endif
}
```

```cpp
#include <hip/hip_runtime.h>
#include <hip/hip_cooperative_groups.h>
#include <cstdio>
#include <cstdint>
namespace cg = cooperative_groups;
namespace pg8 {
#define PG8_LAS __attribute__((address_space(3)))
typedef unsigned short bf16_t;
typedef short bf16x8 __attribute__((ext_vector_type(8)));
typedef float f32x4 __attribute__((ext_vector_type(4)));
typedef unsigned u32x4 __attribute__((ext_vector_type(4)));
constexpr int BM = 256, BK = 64, HALF = 128, HTB = HALF * BK * 2  , STAGE_BYTES = 8 * HTB, NXCD = 8, WGM = 8;

__host__ __device__ __forceinline__ int lds_byte(int r, int c) { const int st = (r >> 4) * 2 + (c >> 5), rr = r & 15, cc = c & 31, ob = rr * 64 + cc * 2; return st * 1024 + (ob ^ (((ob >> 9) & 1) << 5)); }
__host__ __device__ __forceinline__ void stage_rc(int b, int& R, int& C) { const int st = b / 1024, sb = b % 1024, swz = sb ^ (((sb >> 9) & 1) << 5); R = (st >> 1) * 16 + swz / 64; C = (st & 1) * 32 + (swz % 64) / 2; }
__host__ __device__ __forceinline__ int perm32(int rho) { const int n = rho >> 4, i = rho & 15; return 8 * (i >> 2) + 4 * n + (i & 3); }

struct Unit { int pm, pn; };
struct Gemm { const bf16_t* A; const bf16_t* Bt; int M, N, K; };

struct StaticOrder {
    int nM, nN, nwg, G, c;
    __host__ __device__ void init(int M, int N, int G_, int c_) { nM = M / BM; nN = N / BM; nwg = nM * nN; G = G_; c = c_; }
    __host__ __device__ bool next(int i, Unit& u) const {
        const long L = (long)i * G + c; if (L >= nwg) return false;
        int wgid = (int)L; { const int q = nwg / NXCD, r = nwg % NXCD, xcd = wgid % NXCD, off = wgid / NXCD; wgid = (xcd < r ? xcd * (q + 1) : r * (q + 1) + (xcd - r) * q) + off; }
        const int nig = WGM * nN, gid = wgid / nig, fm = gid * WGM, gsz = (nM - fm) < WGM ? (nM - fm) : WGM;
        u.pm = fm + ((wgid % nig) % gsz); u.pn = (wgid % nig) / gsz; return true;
    }
    __device__ __forceinline__ void a_ready(const Unit&) const {}
    __device__ __forceinline__ void done(const Unit&) const {}
};

template <class Epi, class Sched, bool ALIGN_EPI = false, bool SP2 = false>
__device__ __forceinline__ void gemm_phase(PG8_LAS unsigned char* lds, const Gemm g, const Sched& S, const Epi& E) {
    const int tid = threadIdx.x, wid = __builtin_amdgcn_readfirstlane(tid >> 6), lane = tid & 63, wr = wid >> 2, wc = wid & 3, fr = lane & 15, fq = lane >> 4;
    int Kv_ = g.K; asm volatile("" : "+s"(Kv_)); const int K = Kv_, nt = K / BK;
    unsigned voffA[2], voffB[2];
#pragma unroll
    for (int i = 0; i < 2; ++i) { int R, C; stage_rc(tid * 16 + i * 8192, R, C); const int Rb = Epi::PERM ? ((R & ~31) + perm32(R & 31)) : R;
        voffA[i] = (unsigned)(R * K + C) * 2u; voffB[i] = (unsigned)(Rb * K + C) * 2u; }
    const size_t kstep = (size_t)(BK * 2);
    const size_t hstep = (size_t)HALF * K * 2;
    const size_t tstep = 2 * hstep;
    const unsigned ldsw = (unsigned)wid * 1024u;
    const int aoff = lds_byte(wr * 64 + fr, fq * 8), boff = lds_byte(wc * 32 + fr, fq * 8);
#define PG8_SA(b, h) (((b) * 2 + (h)) * HTB)
#define PG8_SB(b, h) ((4 + (b) * 2 + (h)) * HTB)
#define PG8_STAGE(bufoff, gbase, voff) do { _Pragma("unroll") for (int _i = 0; _i < 2; ++_i) \
        __builtin_amdgcn_global_load_lds((const unsigned*)((const char*)(gbase) + (voff)[_i]), (PG8_LAS unsigned*)(lds + (bufoff) + ldsw + _i * 8192), 16, 0, 0); } while (0)
#define PG8_LDA(dst, b, h) do { _Pragma("unroll") for (int m = 0; m < 4; ++m) _Pragma("unroll") for (int k = 0; k < 2; ++k) dst[m][k] = *(const PG8_LAS bf16x8*)(lds + PG8_SA(b, h) + aoff + m * 2048 + k * 1024); } while (0)
#define PG8_LDB(dst, b, h) do { _Pragma("unroll") for (int n = 0; n < 2; ++n) _Pragma("unroll") for (int k = 0; k < 2; ++k) dst[n][k] = *(const PG8_LAS bf16x8*)(lds + PG8_SB(b, h) + boff + n * 2048 + k * 1024); } while (0)
#define PG8_MMA(ai, bj, At, Bt) do { __builtin_amdgcn_s_setprio(1); _Pragma("unroll") for (int m = 0; m < 4; ++m) _Pragma("unroll") for (int n = 0; n < 2; ++n) _Pragma("unroll") for (int k = 0; k < 2; ++k) \
        acc[ai][bj][m][n] = __builtin_amdgcn_mfma_f32_16x16x32_bf16(Bt[n][k], At[m][k], acc[ai][bj][m][n], 0, 0, 0); __builtin_amdgcn_s_setprio(0); } while (0)
#define PG8_WAIT_V(n) asm volatile("s_waitcnt vmcnt(" #n ")" ::: "memory")
#define PG8_WAIT_L(n) asm volatile("s_waitcnt lgkmcnt(" #n ")" ::: "memory")
#define PG8_BAR __builtin_amdgcn_s_barrier()
#define PG8_SCHED __builtin_amdgcn_sched_barrier(0)
    Unit cur, nxt; int ui = 0;
    if (!S.next(0, cur)) return;
    f32x4 acc[2][2][4][2];
#pragma unroll
    for (int a = 0; a < 2; ++a)
#pragma unroll
        for (int b = 0; b < 2; ++b)
#pragma unroll
            for (int m = 0; m < 4; ++m)
#pragma unroll
                for (int n = 0; n < 2; ++n) acc[a][b][m][n] = (f32x4){0.f, 0.f, 0.f, 0.f};
    bf16x8 At[4][2], B0[2][2], B1[2][2];
    const char* cA = (const char*)g.A + (size_t)cur.pm * tstep; const char* cB = (const char*)g.Bt + (size_t)cur.pn * tstep;
    S.a_ready(cur);
    if constexpr (SP2) {
        PG8_STAGE(PG8_SB(0, 0), cB, voffB); PG8_STAGE(PG8_SB(0, 1), cB + hstep, voffB); PG8_STAGE(PG8_SA(0, 0), cA, voffA); PG8_STAGE(PG8_SA(0, 1), cA + hstep, voffA);
        if (wr == 1) PG8_BAR;
        PG8_WAIT_V(2); PG8_BAR;
        PG8_STAGE(PG8_SB(1, 0), cB + kstep, voffB); PG8_STAGE(PG8_SA(1, 0), cA + kstep, voffA); PG8_STAGE(PG8_SB(1, 1), cB + hstep + kstep, voffB);
        PG8_WAIT_V(6); PG8_BAR;
    } else {
        PG8_STAGE(PG8_SB(0, 0), cB, voffB); PG8_STAGE(PG8_SA(0, 0), cA, voffA); PG8_STAGE(PG8_SB(0, 1), cB + hstep, voffB); PG8_STAGE(PG8_SA(0, 1), cA + hstep, voffA);
        if (wr == 1) PG8_BAR;
        PG8_WAIT_V(4); PG8_BAR;
        PG8_STAGE(PG8_SB(1, 0), cB + kstep, voffB); PG8_STAGE(PG8_SA(1, 0), cA + kstep, voffA); PG8_STAGE(PG8_SB(1, 1), cB + hstep + kstep, voffB);
        PG8_WAIT_V(6); PG8_BAR;
    }
    for (;;) {
        const bool has_next = S.next(ui + 1, nxt);
        const char* nA = has_next ? (const char*)g.A + (size_t)nxt.pm * tstep : cA; const char* nB = has_next ? (const char*)g.Bt + (size_t)nxt.pn * tstep : cB;
        for (int t = 0; t < nt; t += 2) {
            if constexpr (Epi::HAS_MID) { if (t == Epi::MID_T) E.mid(acc, cur, wr, wc, fr, fq); }
            const bool last = (t == nt - 2);
            const char* a1 = cA + (size_t)(t + 1) * kstep;
            const char* a2 = last ? nA : cA + (size_t)(t + 2) * kstep; const char* b2 = last ? nB : cB + (size_t)(t + 2) * kstep;
            const char* a3 = a2 + kstep; const char* b3 = b2 + kstep;
            if (last && has_next) S.a_ready(nxt);
            if constexpr (SP2) {
            PG8_LDB(B0, 0, 0); PG8_LDB(B1, 0, 1); PG8_SCHED; PG8_LDA(At, 0, 0); PG8_STAGE(PG8_SA(1, 1), a1 + hstep, voffA);
            PG8_WAIT_V(8); PG8_WAIT_L(0); PG8_BAR; PG8_MMA(0, 0, At, B0); PG8_MMA(0, 1, At, B1); PG8_BAR; PG8_SCHED;
            PG8_LDA(At, 0, 1); PG8_STAGE(PG8_SB(0, 0), b2, voffB); PG8_STAGE(PG8_SB(0, 1), b2 + hstep, voffB); PG8_STAGE(PG8_SA(0, 0), a2, voffA);
            PG8_WAIT_V(8); PG8_WAIT_L(0); PG8_BAR; PG8_MMA(1, 0, At, B0); PG8_MMA(1, 1, At, B1); PG8_BAR; PG8_SCHED;
            PG8_LDB(B0, 1, 0); PG8_LDB(B1, 1, 1); PG8_SCHED; PG8_LDA(At, 1, 0); PG8_STAGE(PG8_SA(0, 1), a2 + hstep, voffA);
            PG8_WAIT_V(8); PG8_WAIT_L(0); PG8_BAR; PG8_MMA(0, 0, At, B0); PG8_MMA(0, 1, At, B1); PG8_BAR; PG8_SCHED;
            PG8_LDA(At, 1, 1); PG8_STAGE(PG8_SB(1, 0), b3, voffB); PG8_STAGE(PG8_SB(1, 1), b3 + hstep, voffB); PG8_STAGE(PG8_SA(1, 0), a3, voffA);
            PG8_WAIT_V(8); PG8_WAIT_L(0); PG8_BAR; PG8_MMA(1, 0, At, B0); PG8_MMA(1, 1, At, B1); PG8_BAR; PG8_SCHED;
            } else {
            PG8_LDB(B0, 0, 0); PG8_SCHED; PG8_LDA(At, 0, 0); PG8_STAGE(PG8_SA(1, 1), a1 + hstep, voffA);
            PG8_WAIT_L(8); PG8_BAR; PG8_WAIT_L(0); PG8_MMA(0, 0, At, B0); PG8_BAR; PG8_SCHED;
            PG8_LDB(B1, 0, 1); PG8_STAGE(PG8_SB(0, 0), b2, voffB);
            PG8_BAR; PG8_WAIT_L(0); PG8_MMA(0, 1, At, B1); PG8_BAR;
            PG8_LDA(At, 0, 1); PG8_STAGE(PG8_SA(0, 0), a2, voffA);
            PG8_BAR; PG8_WAIT_L(0); PG8_MMA(1, 0, At, B0); PG8_BAR; PG8_SCHED;
            PG8_STAGE(PG8_SB(0, 1), b2 + hstep, voffB);
            PG8_WAIT_V(6); PG8_BAR; PG8_MMA(1, 1, At, B1); PG8_BAR;
            PG8_LDB(B0, 1, 0); PG8_SCHED; PG8_LDA(At, 1, 0); PG8_STAGE(PG8_SA(0, 1), a2 + hstep, voffA);
            PG8_WAIT_L(8); PG8_BAR; PG8_WAIT_L(0); PG8_MMA(0, 0, At, B0); PG8_BAR; PG8_SCHED;
            PG8_LDB(B1, 1, 1); PG8_STAGE(PG8_SB(1, 0), b3, voffB);
            PG8_BAR; PG8_WAIT_L(0); PG8_MMA(0, 1, At, B1); PG8_BAR;
            PG8_LDA(At, 1, 1); PG8_STAGE(PG8_SA(1, 0), a3, voffA);
            PG8_BAR; PG8_WAIT_L(0); PG8_MMA(1, 0, At, B0); PG8_BAR; PG8_SCHED;
            PG8_STAGE(PG8_SB(1, 1), b3 + hstep, voffB);
            PG8_WAIT_V(6); PG8_BAR; PG8_MMA(1, 1, At, B1); PG8_BAR;
            }
        }
        if constexpr (ALIGN_EPI) { if (wr == 0) PG8_BAR; }
        if constexpr (!Epi::AFTER_DRAIN) { E(acc, cur, wr, wc, fr, fq); S.done(cur); }
        if (!has_next) break;
#pragma unroll
        for (int a = 0; a < 2; ++a)
#pragma unroll
            for (int b = 0; b < 2; ++b)
#pragma unroll
                for (int m = 0; m < 4; ++m)
#pragma unroll
                    for (int n = 0; n < 2; ++n) acc[a][b][m][n] = (f32x4){0.f, 0.f, 0.f, 0.f};
        cur = nxt; cA = nA; cB = nB; ++ui;
        if constexpr (ALIGN_EPI) { if (wr == 1) PG8_BAR; }
    }
    PG8_WAIT_V(0);
    if constexpr (!ALIGN_EPI) { if (wr == 0) PG8_BAR; }
    PG8_BAR;
    if constexpr (Epi::AFTER_DRAIN) { E.fused(acc, cur, wr, wc, fr, fq, lds, wid, lane); S.done(cur); }
#undef PG8_SA
#undef PG8_SB
#undef PG8_STAGE
#undef PG8_LDA
#undef PG8_LDB
#undef PG8_MMA
#undef PG8_WAIT_V
#undef PG8_WAIT_L
#undef PG8_BAR
#undef PG8_SCHED
}
}
#define LAS __attribute__((address_space(3)))
#define GAS __attribute__((address_space(1)))
using pg8::bf16_t; using pg8::bf16x8; using pg8::f32x4; using pg8::u32x4; using pg8::Unit;
typedef float f32x16 __attribute__((ext_vector_type(16)));
typedef unsigned u32x2 __attribute__((ext_vector_type(2)));
typedef float f32x2_t __attribute__((ext_vector_type(2)));
typedef __bf16 bf16x2_t __attribute__((ext_vector_type(2)));
typedef short v4i16_t __attribute__((ext_vector_type(4)));

constexpr int DM = 1024, NB = 16, SEQ = 2048, T = NB * SEQ;
constexpr int NH = 8, QLORA = 384, KVLORA = 256, NIN = 7872, NINV = 7936;
constexpr float EPS = 1e-6f;
constexpr float QSCALE = 0.07216878364870322f * 1.4426950408889634f;

constexpr size_t MiB = 1u << 20;
constexpr size_t WS_SSQ = 0;
constexpr size_t WS_BAR = 448 * 1024;
constexpr size_t WS_MOD = 512 * 1024;
constexpr size_t WS_ROPE = 1 * MiB;
constexpr size_t WS_WIN = 9 * MiB, WS_WM = 25 * MiB, WS_WUQ = 29 * MiB, WS_WUKV = 30 * MiB + 512 * 1024, WS_WOUT = 32 * MiB;
constexpr size_t WS_KPE = 34 * MiB, WS_QL = 38 * MiB, WS_KVL = 62 * MiB;
constexpr size_t WS_RA = 80 * MiB;
constexpr size_t WS_RB = 144 * MiB;
constexpr size_t WS_A2 = 208 * MiB;
constexpr size_t WS_QIMG = 336 * MiB, WS_VIMG = 432 * MiB, WS_END = 496 * MiB;
constexpr size_t WS_H = WS_QIMG;

constexpr int LDS_BYTES = 147456 + 256;

__device__ __forceinline__ unsigned pk2(float lo, float hi) { f32x2_t v = {lo, hi}; bf16x2_t b = __builtin_convertvector(v, bf16x2_t); return __builtin_bit_cast(unsigned, b); }
__device__ __forceinline__ u32x4 pk8(f32x4 a, f32x4 b) { u32x4 w; w.x = pk2(a[0], a[1]); w.y = pk2(a[2], a[3]); w.z = pk2(b[0], b[1]); w.w = pk2(b[2], b[3]); return w; }
__device__ __forceinline__ float bf_lo(unsigned w) { return __uint_as_float(w << 16); }
__device__ __forceinline__ float bf_hi(unsigned w) { return __uint_as_float(w & 0xffff0000u); }
__device__ __forceinline__ float sigmoidf_(float x) { return __builtin_amdgcn_rcpf(1.0f + __expf(-x)); }
__device__ __forceinline__ f32x4 silu4(f32x4 x) { f32x4 r; for (int i = 0; i < 4; ++i) r[i] = x[i] * sigmoidf_(x[i]); return r; }
__device__ __forceinline__ float sumsq4(f32x4 x) { return (x[0] * x[0] + x[1] * x[1]) + (x[2] * x[2] + x[3] * x[3]); }
__device__ __forceinline__ void st16(bf16_t* p, u32x4 v) { __builtin_nontemporal_store(v, (u32x4*)p); }
__device__ __forceinline__ void st16c(bf16_t* p, u32x4 v) { *(u32x4*)p = v; }

#define ROW_OF(ai, m) (u.pm * 256 + (ai) * 128 + wr * 64 + (m) * 16 + fr)
typedef f32x4 AccT[2][2][4][2];

struct EpiInProj {
    static constexpr bool PERM = true, AFTER_DRAIN = false, HAS_MID = false; static constexpr int MID_T = 0;
    unsigned char* ws; float* out;
    __device__ __forceinline__ void mid(AccT&, const Unit&, int, int, int, int) const {}
    __device__ __forceinline__ void operator()(const AccT& acc, const Unit& u, int wr, int wc, int fr_, int fq_) const {
        int fr = fr_, fq = fq_; asm volatile("" : "+v"(fr), "+v"(fq));
        const int pn = u.pn < 8 ? u.pn : u.pn + 8, cb = wc * 32 + 8 * fq;
        bf16_t* const U = (bf16_t*)(ws + WS_RB); bf16_t* const A2 = (bf16_t*)(ws + WS_A2); bf16_t* const QL = (bf16_t*)(ws + WS_QL); bf16_t* const KVL = (bf16_t*)(ws + WS_KVL); bf16_t* const KPE = (bf16_t*)(ws + WS_KPE);
        bf16_t* const R = (bf16_t*)out; bf16_t* const SB = (bf16_t*)out + (size_t)T * 1024; float* const ssq_q = (float*)(ws + WS_SSQ); float* const ssq_kv = ssq_q + T; const float* const rope = (const float*)(ws + WS_ROPE);
#pragma unroll
        for (int ai = 0; ai < 2; ++ai)
#pragma unroll
            for (int m = 0; m < 4; ++m) {
                const size_t row = (size_t)ROW_OF(ai, m);
                const f32x4 a0 = acc[ai][0][m][0], a1 = acc[ai][0][m][1], b0 = acc[ai][1][m][0], b1 = acc[ai][1][m][1];
                if (pn < 8) {
                    st16c(U + row * 1024 + pn * 128 + cb, pk8(a0 * b0, a1 * b1));
                } else if (pn == 16) {
                    st16c(QL + row * 384 + cb, pk8(a0, a1)); st16c(QL + row * 384 + 128 + cb, pk8(b0, b1));
                    float s = (sumsq4(a0) + sumsq4(a1)) + (sumsq4(b0) + sumsq4(b1));
                    s += __shfl_xor(s, 16); s += __shfl_xor(s, 32);
                    if (fq == 0) atomicAdd(ssq_q + row, s);
                } else if (pn == 17) {
                    st16c(QL + row * 384 + 256 + cb, pk8(a0, a1)); st16c(KVL + row * 256 + cb, pk8(b0, b1));
                    float s = sumsq4(a0) + sumsq4(a1), s2 = sumsq4(b0) + sumsq4(b1);
                    s += __shfl_xor(s, 16); s += __shfl_xor(s, 32); s2 += __shfl_xor(s2, 16); s2 += __shfl_xor(s2, 32);
                    if (fq == 0) { atomicAdd(ssq_q + row, s); atomicAdd(ssq_kv + row, s2); }
                } else if (pn == 18) {
                    if (wc < 2) {
                        st16c(KVL + row * 256 + 128 + cb, pk8(a0, a1)); st16c(KVL + row * 256 + 192 + cb, pk8(b0, b1));
                        float s = (sumsq4(a0) + sumsq4(a1)) + (sumsq4(b0) + sumsq4(b1));
                        s += __shfl_xor(s, 16); s += __shfl_xor(s, 32);
                        if (fq == 0) atomicAdd(ssq_kv + row, s);
                    } else if (wc == 2) {
                        const f32x4* cs = (const f32x4*)(rope + row * 64 + 16 * fq);
                        const f32x4 c0 = cs[0], c1 = cs[1], c2 = cs[2], c3 = cs[3];
                        f32x4 o1a, o1b, o2a, o2b;
                        o1a[0] = a0[0] * c0[0] - b0[0] * c0[1]; o2a[0] = a0[0] * c0[1] + b0[0] * c0[0];
                        o1a[1] = a0[1] * c0[2] - b0[1] * c0[3]; o2a[1] = a0[1] * c0[3] + b0[1] * c0[2];
                        o1a[2] = a0[2] * c1[0] - b0[2] * c1[1]; o2a[2] = a0[2] * c1[1] + b0[2] * c1[0];
                        o1a[3] = a0[3] * c1[2] - b0[3] * c1[3]; o2a[3] = a0[3] * c1[3] + b0[3] * c1[2];
                        o1b[0] = a1[0] * c2[0] - b1[0] * c2[1]; o2b[0] = a1[0] * c2[1] + b1[0] * c2[0];
                        o1b[1] = a1[1] * c2[2] - b1[1] * c2[3]; o2b[1] = a1[1] * c2[3] + b1[1] * c2[2];
                        o1b[2] = a1[2] * c3[0] - b1[2] * c3[1]; o2b[2] = a1[2] * c3[1] + b1[2] * c3[0];
                        o1b[3] = a1[3] * c3[2] - b1[3] * c3[3]; o2b[3] = a1[3] * c3[3] + b1[3] * c3[2];
                        bf16_t* base = KPE + (row >> 5) * 2048 + (row & 31) * 8 + (fq & 1) * 256;
                        st16(base + (fq >> 1) * 512, pk8(o1a, o1b)); st16(base + (2 + (fq >> 1)) * 512, pk8(o2a, o2b));
                    }
                } else if (pn < 23) {
                    bf16_t* p = A2 + row * 2048 + 1024 + (pn - 19) * 256 + cb;
                    st16(p, pk8(silu4(a0), silu4(a1))); st16(p + 128, pk8(silu4(b0), silu4(b1)));
                } else {
                    f32x4 r0, r1, s0, s1;
#pragma unroll
                    for (int j = 0; j < 4; ++j) {
                        const float ea0 = 1.0f + __expf(-a0[j]), eb0 = 1.0f + __expf(-b0[j]), ea1 = 1.0f + __expf(-a1[j]), eb1 = 1.0f + __expf(-b1[j]);
                        s0[j] = __builtin_amdgcn_rcpf(eb0); s1[j] = __builtin_amdgcn_rcpf(eb1);
                        r0[j] = eb0 * __builtin_amdgcn_rcpf(ea0); r1[j] = eb1 * __builtin_amdgcn_rcpf(ea1);
                    }
                    st16(R + row * 1024 + (pn - 23) * 128 + cb, pk8(r0, r1)); st16(SB + row * 1024 + (pn - 23) * 128 + cb, pk8(s0, s1));
                }
            }
    }
};

struct EpiConv {
    static constexpr bool PERM = true, AFTER_DRAIN = false, HAS_MID = false; static constexpr int MID_T = 0;
    unsigned char* ws; const float* conv_w;
    __device__ __forceinline__ void mid(AccT&, const Unit&, int, int, int, int) const {}
    __device__ __forceinline__ void operator()(const AccT& acc, const Unit& u, int wr, int wc, int fr_, int fq_) const {
        int fr = fr_, fq = fq_; asm volatile("" : "+v"(fr), "+v"(fq));
        const int c0 = u.pn * 128 + wc * 32 + 8 * fq;
        const bf16_t* const U = (const bf16_t*)(ws + WS_RB); bf16_t* const A2 = (bf16_t*)(ws + WS_A2);
        const f32x4 w0a = *(const f32x4*)(conv_w + c0), w0b = *(const f32x4*)(conv_w + c0 + 4);
        const f32x4 w1a = *(const f32x4*)(conv_w + 1024 + c0), w1b = *(const f32x4*)(conv_w + 1024 + c0 + 4);
        const f32x4 w2a = *(const f32x4*)(conv_w + 2048 + c0), w2b = *(const f32x4*)(conv_w + 2048 + c0 + 4);
#pragma unroll
        for (int ai = 0; ai < 2; ++ai) {
            u32x4 uu[4][3];
#pragma unroll
            for (int m = 0; m < 4; ++m) { const size_t row = (size_t)ROW_OF(ai, m); const int s = (int)(row & 2047); const u32x4 z4 = {0u, 0u, 0u, 0u};
                uu[m][2] = *(const u32x4*)(U + row * 1024 + c0);
                uu[m][1] = s >= 1 ? *(const u32x4*)(U + (row - 1) * 1024 + c0) : z4;
                uu[m][0] = s >= 2 ? *(const u32x4*)(U + (row - 2) * 1024 + c0) : z4; }
#pragma unroll
            for (int m = 0; m < 4; ++m) { const size_t row = (size_t)ROW_OF(ai, m);
                const u32x4 u0 = uu[m][0], u1 = uu[m][1], u2 = uu[m][2];
                const f32x4 ga = acc[ai][0][m][0] * silu4(acc[ai][1][m][0]), gb = acc[ai][0][m][1] * silu4(acc[ai][1][m][1]);
                const f32x4 ca = w0a * (f32x4){bf_lo(u0.x), bf_hi(u0.x), bf_lo(u0.y), bf_hi(u0.y)} + w1a * (f32x4){bf_lo(u1.x), bf_hi(u1.x), bf_lo(u1.y), bf_hi(u1.y)} + w2a * (f32x4){bf_lo(u2.x), bf_hi(u2.x), bf_lo(u2.y), bf_hi(u2.y)};
                const f32x4 cbv = w0b * (f32x4){bf_lo(u0.z), bf_hi(u0.z), bf_lo(u0.w), bf_hi(u0.w)} + w1b * (f32x4){bf_lo(u1.z), bf_hi(u1.z), bf_lo(u1.w), bf_hi(u1.w)} + w2b * (f32x4){bf_lo(u2.z), bf_hi(u2.z), bf_lo(u2.w), bf_hi(u2.w)};
                st16(A2 + row * 2048 + c0, pk8(ga * ca, gb * cbv)); }
            asm volatile("" ::: "memory");
        }
    }
};

struct EpiQUp {
    static constexpr bool PERM = true, AFTER_DRAIN = false, HAS_MID = false; static constexpr int MID_T = 0;
    unsigned char* ws;
    __device__ __forceinline__ void mid(AccT&, const Unit&, int, int, int, int) const {}
    __device__ __forceinline__ void operator()(const AccT& acc, const Unit& u, int wr, int wc, int fr_, int fq_) const {
        int fr = fr_, fq = fq_; asm volatile("" : "+v"(fr), "+v"(fq));
        const int pn = u.pn;
        bf16_t* const QI = (bf16_t*)(ws + WS_QIMG); const float* const ssq_q = (const float*)(ws + WS_SSQ); const float* const rope = (const float*)(ws + WS_ROPE);
        float ssv[2][4];
#pragma unroll
        for (int ai = 0; ai < 2; ++ai)
#pragma unroll
            for (int m = 0; m < 4; ++m) ssv[ai][m] = ssq_q[(size_t)ROW_OF(ai, m)];
#pragma unroll
        for (int aim = 0; aim < 4; ++aim) { const int ai = aim >> 1;
            f32x4 cs[4][4];
            if (pn >= 4) {
#pragma unroll
                for (int m = 2 * (aim & 1); m < 2 * (aim & 1) + 2; ++m) { const f32x4* cp = (const f32x4*)(rope + (size_t)ROW_OF(ai, m) * 64 + 16 * fq);
#pragma unroll
                    for (int j = 0; j < 4; ++j) cs[m][j] = cp[j]; }
            }
#pragma unroll
            for (int m = 2 * (aim & 1); m < 2 * (aim & 1) + 2; ++m) {
                const size_t row = (size_t)ROW_OF(ai, m);
                const float sc = QSCALE * __builtin_amdgcn_rsqf(ssv[ai][m] * (1.0f / QLORA) + EPS);
                const int b = (int)(row >> 11), s = (int)(row & 2047);
                const f32x4 a0 = acc[ai][0][m][0] * sc, a1 = acc[ai][0][m][1] * sc, b0 = acc[ai][1][m][0] * sc, b1 = acc[ai][1][m][1] * sc;
                if (pn < 4) {
                    const int ks = 2 * wc + (fq >> 1), h = fq & 1;
                    bf16_t* p = QI + ((size_t)((b * 8 + 2 * pn) * 64 + (s >> 5))) * 6144 + (ks * 2 + h) * 256 + (s & 31) * 8;
                    st16(p, pk8(a0, a1)); st16(p + (size_t)64 * 6144, pk8(b0, b1));
                } else {
                    const int head = 4 * (pn - 4) + wc;
                    const f32x4 c0 = cs[m][0], c1 = cs[m][1], c2 = cs[m][2], c3 = cs[m][3];
                    f32x4 o1a, o1b, o2a, o2b;
                    o1a[0] = a0[0] * c0[0] - b0[0] * c0[1]; o2a[0] = a0[0] * c0[1] + b0[0] * c0[0];
                    o1a[1] = a0[1] * c0[2] - b0[1] * c0[3]; o2a[1] = a0[1] * c0[3] + b0[1] * c0[2];
                    o1a[2] = a0[2] * c1[0] - b0[2] * c1[1]; o2a[2] = a0[2] * c1[1] + b0[2] * c1[0];
                    o1a[3] = a0[3] * c1[2] - b0[3] * c1[3]; o2a[3] = a0[3] * c1[3] + b0[3] * c1[2];
                    o1b[0] = a1[0] * c2[0] - b1[0] * c2[1]; o2b[0] = a1[0] * c2[1] + b1[0] * c2[0];
                    o1b[1] = a1[1] * c2[2] - b1[1] * c2[3]; o2b[1] = a1[1] * c2[3] + b1[1] * c2[2];
                    o1b[2] = a1[2] * c3[0] - b1[2] * c3[1]; o2b[2] = a1[2] * c3[1] + b1[2] * c3[0];
                    o1b[3] = a1[3] * c3[2] - b1[3] * c3[3]; o2b[3] = a1[3] * c3[3] + b1[3] * c3[2];
                    bf16_t* p = QI + ((size_t)((b * 8 + head) * 64 + (s >> 5))) * 6144 + (fq & 1) * 256 + (s & 31) * 8;
                    st16(p + (8 + (fq >> 1)) * 512, pk8(o1a, o1b)); st16(p + (10 + (fq >> 1)) * 512, pk8(o2a, o2b));
                }
            }
            asm volatile("" ::: "memory");
        }
    }
};

struct EpiKVUp {
    static constexpr bool PERM = true, AFTER_DRAIN = false, HAS_MID = false; static constexpr int MID_T = 0;
    unsigned char* ws;
    __device__ __forceinline__ void mid(AccT&, const Unit&, int, int, int, int) const {}
    __device__ __forceinline__ void operator()(const AccT& acc, const Unit& u, int wr, int wc, int fr_, int fq_) const {
        int fr = fr_, fq = fq_; asm volatile("" : "+v"(fr), "+v"(fq));
        const int pn = u.pn;
        bf16_t* const KN = (bf16_t*)(ws + WS_RA); bf16_t* const VI = (bf16_t*)(ws + WS_VIMG); const float* const ssq_kv = (const float*)(ws + WS_SSQ) + T;
        float ssv[2][4];
#pragma unroll
        for (int ai = 0; ai < 2; ++ai)
#pragma unroll
            for (int m = 0; m < 4; ++m) ssv[ai][m] = ssq_kv[(size_t)ROW_OF(ai, m)];
#pragma unroll
        for (int ai = 0; ai < 2; ++ai)
#pragma unroll
            for (int m = 0; m < 4; ++m) {
                const size_t row = (size_t)ROW_OF(ai, m);
                const float sc = __builtin_amdgcn_rsqf(ssv[ai][m] * (1.0f / KVLORA) + EPS);
                const int b = (int)(row >> 11), s = (int)(row & 2047);
                const f32x4 a0 = acc[ai][0][m][0] * sc, a1 = acc[ai][0][m][1] * sc, b0 = acc[ai][1][m][0] * sc, b1 = acc[ai][1][m][1] * sc;
                if (pn < 4) {
                    const int ks = 2 * wc + (fq >> 1), h = fq & 1;
                    bf16_t* p = KN + ((size_t)((b * 8 + 2 * pn) * 64 + (s >> 5))) * 4096 + (ks * 2 + h) * 256 + (s & 31) * 8;
                    st16(p, pk8(a0, a1)); st16(p + (size_t)64 * 4096, pk8(b0, b1));
                } else {
                    bf16_t* p = VI + ((size_t)((b * 8 + 2 * (pn - 4)) * 256 + (s >> 3))) * 1024 + wc * 256 + (s & 7) * 32 + 8 * fq;
                    st16(p, pk8(a0, a1)); st16(p + (size_t)256 * 1024, pk8(b0, b1));
                }
            }
    }
};

struct EpiMerge {
    static constexpr bool PERM = true, AFTER_DRAIN = false, HAS_MID = true; static constexpr int MID_T = 16;
    unsigned char* ws; float* out;
    __device__ __forceinline__ void mid(AccT& acc, const Unit& u, int wr, int wc, int fr_, int fq_) const {
        int fr = fr_, fq = fq_; asm volatile("" : "+v"(fr), "+v"(fq));
        const bf16_t* const R = (const bf16_t*)out;
        u32x4 w[2][4][2];
#pragma unroll
        for (int ai = 0; ai < 2; ++ai)
#pragma unroll
            for (int m = 0; m < 4; ++m)
#pragma unroll
                for (int bj = 0; bj < 2; ++bj) w[ai][m][bj] = *(const u32x4*)(R + (size_t)ROW_OF(ai, m) * 1024 + u.pn * 256 + bj * 128 + wc * 32 + 8 * fq);
#pragma unroll
        for (int ai = 0; ai < 2; ++ai)
#pragma unroll
            for (int m = 0; m < 4; ++m)
#pragma unroll
                for (int bj = 0; bj < 2; ++bj) { const u32x4 v = w[ai][m][bj];
                    acc[ai][bj][m][0] *= (f32x4){bf_lo(v.x), bf_hi(v.x), bf_lo(v.y), bf_hi(v.y)};
                    acc[ai][bj][m][1] *= (f32x4){bf_lo(v.z), bf_hi(v.z), bf_lo(v.w), bf_hi(v.w)}; }
        asm volatile("" ::: "memory");
    }
    __device__ __forceinline__ void operator()(const AccT& acc, const Unit& u, int wr, int wc, int fr_, int fq_) const {
        int fr = fr_, fq = fq_; asm volatile("" : "+v"(fr), "+v"(fq));
        const bf16_t* const SB = (const bf16_t*)out + (size_t)T * 1024; bf16_t* const M = (bf16_t*)(ws + WS_RA);
        u32x4 w[2][4][2];
#pragma unroll
        for (int ai = 0; ai < 2; ++ai)
#pragma unroll
            for (int m = 0; m < 4; ++m)
#pragma unroll
                for (int bj = 0; bj < 2; ++bj) w[ai][m][bj] = *(const u32x4*)(SB + (size_t)ROW_OF(ai, m) * 1024 + u.pn * 256 + bj * 128 + wc * 32 + 8 * fq);
#pragma unroll
        for (int ai = 0; ai < 2; ++ai)
#pragma unroll
            for (int m = 0; m < 4; ++m)
#pragma unroll
                for (int bj = 0; bj < 2; ++bj) { const u32x4 v = w[ai][m][bj];
                    const size_t off = (size_t)ROW_OF(ai, m) * 1024 + u.pn * 256 + bj * 128 + wc * 32 + 8 * fq;
                    const f32x4 v0 = acc[ai][bj][m][0] * (f32x4){bf_lo(v.x), bf_hi(v.x), bf_lo(v.y), bf_hi(v.y)};
                    const f32x4 v1 = acc[ai][bj][m][1] * (f32x4){bf_lo(v.z), bf_hi(v.z), bf_lo(v.w), bf_hi(v.w)};
                    st16c(M + off, pk8(v0, v1)); }
    }
};

struct EpiOut {
    static constexpr bool PERM = true, AFTER_DRAIN = false, HAS_MID = false; static constexpr int MID_T = 0;
    unsigned char* ws;
    __device__ __forceinline__ void mid(AccT&, const Unit&, int, int, int, int) const {}
    __device__ __forceinline__ void operator()(const AccT& acc, const Unit& u, int wr, int wc, int fr_, int fq_) const {
        int fr = fr_, fq = fq_; asm volatile("" : "+v"(fr), "+v"(fq));
        bf16_t* const O = (bf16_t*)(ws + WS_RB);
#pragma unroll
        for (int ai = 0; ai < 2; ++ai)
#pragma unroll
            for (int m = 0; m < 4; ++m) {
                const size_t row = (size_t)ROW_OF(ai, m);
#pragma unroll
                for (int bj = 0; bj < 2; ++bj)
                    st16c(O + row * 1024 + u.pn * 256 + bj * 128 + wc * 32 + 8 * fq, pk8(acc[ai][bj][m][0], acc[ai][bj][m][1]));
            }
    }
};

__device__ __forceinline__ float wave_sum(float v) {
#pragma unroll
    for (int o = 1; o < 64; o <<= 1) v += __shfl_xor(v, o);
    return v;
}
__device__ __forceinline__ void transpose_item(const float* W, int ldw, int k0, int srcn0, bf16_t* WT, int ldk, int dstrow0, int dstk0, const float* ksc, LAS float* scr, int lane) {
    float tv[32];
#pragma unroll
    for (int i = 0; i < 32; ++i) { const int kk = 2 * i + (lane >> 5); tv[i] = 0.f;
        if (srcn0 >= 0) { tv[i] = __builtin_nontemporal_load(W + (size_t)(k0 + kk) * ldw + srcn0 + (lane & 31)); } }
#pragma unroll
    for (int i = 0; i < 32; ++i) { const int kk = 2 * i + (lane >> 5); float v = tv[i]; if (srcn0 >= 0 && ksc) v *= ksc[k0 + kk];
        scr[kk * 33 + (lane & 31)] = v; }
    asm volatile("s_waitcnt lgkmcnt(0)" ::: "memory");
    const int c = lane & 7;
#pragma unroll
    for (int j = 0; j < 4; ++j) { const int n = (lane >> 3) + 8 * j; const LAS float* s = scr + (8 * c) * 33 + n;
        u32x4 o; o.x = pk2(s[0 * 33], s[1 * 33]); o.y = pk2(s[2 * 33], s[3 * 33]); o.z = pk2(s[4 * 33], s[5 * 33]); o.w = pk2(s[6 * 33], s[7 * 33]);
        *(u32x4*)(WT + (size_t)(dstrow0 + n) * ldk + dstk0 + 8 * c) = o; }
    asm volatile("s_waitcnt lgkmcnt(0)" ::: "memory");
}
__device__ __forceinline__ int win_src(int vg) {
    const int tnew = vg >> 3, tile = tnew < 8 ? tnew : (tnew < 23 ? tnew + 8 : tnew - 15), half = (vg >> 2) & 1, wc = vg & 3;
    if (tile < 8) return (half ? 2048 : 0) + 128 * tile + 32 * wc;
    if (tile < 16) return (half ? 3072 : 1024) + 128 * (tile - 8) + 32 * wc;
    if (tile == 16) return 4096 + 32 * (vg & 7);
    if (tile == 17) return half ? 4480 + 32 * wc : 4352 + 32 * wc;
    if (tile == 18) return wc < 2 ? 4608 + 64 * half + 32 * wc : (wc == 2 ? 4736 + 32 * half : -1);
    if (tile < 23) return 4800 + 256 * (tile - 19) + 32 * (vg & 7);
    return (half ? 6848 : 5824) + 128 * (tile - 23) + 32 * wc;
}
__device__ __forceinline__ int wuq_src(int vg) {
    const int tile = vg >> 3;
    if (tile < 4) { const int col = vg * 32; return (col >> 7) * 192 + (col & 127); }
    const int half = (vg >> 2) & 1, wc = vg & 3; return (4 * (tile - 4) + wc) * 192 + 128 + 32 * half;
}
__device__ __forceinline__ int wukv_src(int vg) {
    const int col = vg * 32;
    if (col < 1024) return (col >> 7) * 256 + (col & 127);
    const int c2 = col - 1024; return (c2 >> 7) * 256 + 128 + (c2 & 127);
}

struct Ptrs {
    const float *x, *c, *w_ada, *b_ada, *g_pre, *w_in, *conv_w, *w_conv_out, *g_q, *w_uq, *g_kv, *w_ukv, *w_mla_out, *w_out, *g_post; const int* positions;
    float* out; unsigned char* ws;
};

__device__ __forceinline__ void phase0(const Ptrs& P, LAS unsigned char* lds, int G) {
    const int tid = threadIdx.x, lane = tid & 63, wave = __builtin_amdgcn_readfirstlane(tid >> 6);
    const int gt = blockIdx.x * 512 + tid, NGT = G * 512;
    if (blockIdx.x < 96) { LAS float* cl = (LAS float*)lds; LAS float* red = (LAS float*)(lds + 65536); float* mod = (float*)(P.ws + WS_MOD);
      for (int i = tid; i < 16384; i += 512) cl[i] = P.c[i];
      __syncthreads();
      for (int item = blockIdx.x; item < 96; item += G) {
          const int n0 = item * 32, kh = lane >> 5, col = lane & 31; float acc[16];
#pragma unroll
          for (int b = 0; b < 16; ++b) acc[b] = 0.f;
#pragma unroll 8
          for (int it = 0; it < 64; ++it) { const int k = wave * 128 + 2 * it + kh; const float wv = __builtin_nontemporal_load(P.w_ada + (size_t)k * 3072 + n0 + col);
#pragma unroll
              for (int b = 0; b < 16; ++b) acc[b] += cl[b * 1024 + k] * wv; }
#pragma unroll
          for (int b = 0; b < 16; ++b) { acc[b] += __shfl_xor(acc[b], 32); if (lane < 32) red[(wave * 16 + b) * 32 + col] = acc[b]; }
          __syncthreads();
          { const int b = tid >> 5, c2 = tid & 31; float sm = P.b_ada[n0 + c2];
#pragma unroll
            for (int w = 0; w < 8; ++w) sm += red[(w * 16 + b) * 32 + c2];
            mod[b * 3072 + n0 + c2] = sm; }
          __syncthreads();
      } }
    if (blockIdx.x < 96) {
        asm volatile("s_waitcnt vmcnt(0)" ::: "memory"); __syncthreads();
        if (tid == 0) { __builtin_amdgcn_fence(__ATOMIC_RELEASE, "agent"); asm volatile("s_waitcnt vmcnt(0)" ::: "memory");
            __hip_atomic_fetch_add((unsigned*)(P.ws + WS_BAR) + 3520, 1u, __ATOMIC_RELAXED, __HIP_MEMORY_SCOPE_AGENT); }
    }
    float* ssq = (float*)(P.ws + WS_SSQ);
    for (int i = gt; i < 3 * T; i += NGT) ssq[i] = 0.f;
    { float* rope = (float*)(P.ws + WS_ROPE);
      for (int i = gt; i < T * 32; i += NGT) { const int row = i >> 5, j = i & 31;
          const float inv = exp2f(-(float)j * (13.287712379549449f / 32.0f));
          const float ang = (float)P.positions[row] * inv;
          const double rev = (double)ang * 0.15915494309189535; const float fr = (float)(rev - rint(rev));
          float sn, cs; { const float a = fr * 6.283185307179586f; sn = __sinf(a); cs = __cosf(a); }
          *(f32x2_t*)(rope + (size_t)i * 2) = (f32x2_t){cs, sn}; } }
    __syncthreads();
    { LAS float* scr = (LAS float*)(lds + wave * 16384);
      const int first = G > 128 ? 96 : 0;
      const int gw = ((int)blockIdx.x - first) * 8 + wave, NGW = (G - first) * 8;
      bf16_t* WIN = (bf16_t*)(P.ws + WS_WIN); bf16_t* WM = (bf16_t*)(P.ws + WS_WM); bf16_t* WUQ = (bf16_t*)(P.ws + WS_WUQ); bf16_t* WUKV = (bf16_t*)(P.ws + WS_WUKV); bf16_t* WOUT = (bf16_t*)(P.ws + WS_WOUT);
      constexpr int I_IN = 16 * 248, I_M = 32 * 32, I_UQ = 6 * 48, I_UKV = 4 * 64, I_OUT = 16 * 32, NITEMS = I_IN + I_M + I_UQ + I_UKV + I_OUT;
      if ((int)blockIdx.x >= first)
      for (int it = gw; it < NITEMS; it += NGW) {
          int r = it;
          if (r < I_IN) { const int kb = r / 248, vg = r % 248; transpose_item(P.w_in, NIN, kb * 64, win_src(vg), WIN, 1024, vg * 32, kb * 64, nullptr, scr, lane); continue; } r -= I_IN;
          if (r < I_M) { const int kb = r >> 5, nb = r & 31; if (kb < 16) transpose_item(P.w_conv_out, 1024, kb * 64, nb * 32, WM, 2048, nb * 32, kb * 64, nullptr, scr, lane);
                         else transpose_item(P.w_mla_out, 1024, (kb - 16) * 64, nb * 32, WM, 2048, nb * 32, kb * 64, nullptr, scr, lane); continue; } r -= I_M;
          if (r < I_UQ) { const int kb = r / 48, vg = r % 48; transpose_item(P.w_uq, 1536, kb * 64, wuq_src(vg), WUQ, QLORA, vg * 32, kb * 64, P.g_q, scr, lane); continue; } r -= I_UQ;
          if (r < I_UKV) { const int kb = r >> 6, vg = r & 63; transpose_item(P.w_ukv, 2048, kb * 64, wukv_src(vg), WUKV, KVLORA, vg * 32, kb * 64, P.g_kv, scr, lane); continue; } r -= I_UKV;
          { const int kb = r >> 5, nb = r & 31; transpose_item(P.w_out, 1024, kb * 64, nb * 32, WOUT, 1024, nb * 32, kb * 64, nullptr, scr, lane); }
      } }
}

__device__ __forceinline__ void phase1(const Ptrs& P, int G) {
    const int tid = threadIdx.x, lane = tid & 63, wave = tid >> 6;
    const int gw = blockIdx.x * 8 + wave, NGW = G * 8;
    const float* mod = (const float*)(P.ws + WS_MOD); bf16_t* H = (bf16_t*)(P.ws + WS_H);
    if (tid == 0) {
        unsigned* cnt = (unsigned*)(P.ws + WS_BAR) + 3520; const unsigned want = G < 96 ? (unsigned)G : 96u; unsigned sp = 0;
        while (__hip_atomic_load(cnt, __ATOMIC_RELAXED, __HIP_MEMORY_SCOPE_AGENT) < want) { __builtin_amdgcn_s_sleep(2); if (++sp > (1u << 22)) break; }
        __builtin_amdgcn_fence(__ATOMIC_ACQUIRE, "agent"); asm volatile("s_waitcnt vmcnt(0)" ::: "memory");
    }
    __syncthreads();
    for (int row0 = gw; row0 < T; row0 += 2 * NGW) {
        f32x4 v[2][4]; float s[2] = {0.f, 0.f};
#pragma unroll
        for (int r = 0; r < 2; ++r) { const int row = row0 + r * NGW; if (row < T) { const f32x4* xr = (const f32x4*)(P.x + (size_t)row * DM) + lane;
#pragma unroll
            for (int j = 0; j < 4; ++j) v[r][j] = __builtin_nontemporal_load(xr + 64 * j); } }
#pragma unroll
        for (int r = 0; r < 2; ++r) { const int row = row0 + r * NGW; if (row < T) {
#pragma unroll
            for (int j = 0; j < 4; ++j) s[r] += sumsq4(v[r][j]);
            const int b = row >> 11;
            const float rstd = __builtin_amdgcn_rsqf(wave_sum(s[r]) * (1.0f / DM) + EPS);
            u32x2* o8 = (u32x2*)(H + (size_t)row * DM) + lane;
#pragma unroll
            for (int j = 0; j < 4; ++j) {
                const int col = 256 * j + 4 * lane;
                const f32x4 g = *(const f32x4*)(P.g_pre + col), sh = *(const f32x4*)(mod + b * 3072 + col), sc = *(const f32x4*)(mod + b * 3072 + 1024 + col);
                const f32x4 h = v[r][j] * rstd * g * (sc + 1.0f) + sh;
                u32x2 w; w.x = pk2(h[0], h[1]); w.y = pk2(h[2], h[3]); o8[64 * j] = w;
            } } }
    }
}

__device__ __forceinline__ void conv_pass(const Ptrs& P, int G) {
    const int gt = blockIdx.x * 512 + threadIdx.x, NGT = G * 512;
    const bf16_t* U = (const bf16_t*)(P.ws + WS_RB); bf16_t* A2 = (bf16_t*)(P.ws + WS_A2);
    for (int i = gt; i < T * 128; i += NGT) {
        const int row = i >> 7, c0 = (i & 127) * 8, s = row & 2047;
        const u32x4 z4 = {0u, 0u, 0u, 0u};
        const u32x4 u2 = *(const u32x4*)(U + (size_t)row * 1024 + c0);
        const u32x4 u1 = s >= 1 ? *(const u32x4*)(U + (size_t)(row - 1) * 1024 + c0) : z4;
        const u32x4 u0 = s >= 2 ? *(const u32x4*)(U + (size_t)(row - 2) * 1024 + c0) : z4;
        const u32x4 gz = *(const u32x4*)(A2 + (size_t)row * 2048 + c0);
        const f32x4 w0a = *(const f32x4*)(P.conv_w + c0), w0b = *(const f32x4*)(P.conv_w + c0 + 4);
        const f32x4 w1a = *(const f32x4*)(P.conv_w + 1024 + c0), w1b = *(const f32x4*)(P.conv_w + 1024 + c0 + 4);
        const f32x4 w2a = *(const f32x4*)(P.conv_w + 2048 + c0), w2b = *(const f32x4*)(P.conv_w + 2048 + c0 + 4);
        f32x4 ya, yb;
#define CV(W, k) (k == 0 ? bf_lo(W.x) : k == 1 ? bf_hi(W.x) : k == 2 ? bf_lo(W.y) : k == 3 ? bf_hi(W.y) : k == 4 ? bf_lo(W.z) : k == 5 ? bf_hi(W.z) : k == 6 ? bf_lo(W.w) : bf_hi(W.w))
#pragma unroll
        for (int k = 0; k < 4; ++k) {
            ya[k] = CV(gz, k) * (w0a[k] * CV(u0, k) + w1a[k] * CV(u1, k) + w2a[k] * CV(u2, k));
            yb[k] = CV(gz, (k + 4)) * (w0b[k] * CV(u0, (k + 4)) + w1b[k] * CV(u1, (k + 4)) + w2b[k] * CV(u2, (k + 4)));
        }
#undef CV
        *(u32x4*)(A2 + (size_t)row * 2048 + c0) = pk8(ya, yb);
    }
}

__device__ __forceinline__ void final_pass(const Ptrs& P, int G) {
    const int tid = threadIdx.x, lane = tid & 63, wave = tid >> 6;
    const int gw = blockIdx.x * 8 + wave, NGW = G * 8;
    const bf16_t* O = (const bf16_t*)(P.ws + WS_RB); const float* mod = (const float*)(P.ws + WS_MOD);
    f32x4 gp[4];
#pragma unroll
    for (int j = 0; j < 4; ++j) gp[j] = *(const f32x4*)(P.g_post + 256 * j + 4 * lane);
    for (int row0 = gw; row0 < T; row0 += 2 * NGW) {
        u32x2 ov[2][4]; f32x4 xv[2][4], gt[2][4];
#pragma unroll
        for (int r = 0; r < 2; ++r) { const int row = row0 + r * NGW; if (row < T) { const int b = row >> 11;
            const u32x2* op = (const u32x2*)(O + (size_t)row * DM) + lane; const f32x4* xr = (const f32x4*)(P.x + (size_t)row * DM) + lane;
#pragma unroll
            for (int j = 0; j < 4; ++j) { ov[r][j] = op[64 * j]; xv[r][j] = xr[64 * j]; gt[r][j] = *(const f32x4*)(mod + b * 3072 + 2048 + 256 * j + 4 * lane); } } }
#pragma unroll
        for (int r = 0; r < 2; ++r) { const int row = row0 + r * NGW; if (row < T) {
            f32x4 of[4]; float s = 0.f;
#pragma unroll
            for (int j = 0; j < 4; ++j) { of[j] = (f32x4){bf_lo(ov[r][j].x), bf_hi(ov[r][j].x), bf_lo(ov[r][j].y), bf_hi(ov[r][j].y)}; s += sumsq4(of[j]); }
            const float rstd = __builtin_amdgcn_rsqf(wave_sum(s) * (1.0f / DM) + EPS);
            f32x4* outp = (f32x4*)(P.out + (size_t)row * DM) + lane;
#pragma unroll
            for (int j = 0; j < 4; ++j) __builtin_nontemporal_store(xv[r][j] + gt[r][j] * gp[j] * of[j] * rstd, outp + 64 * j);
        } }
    }
}

constexpr int ATT_STAGE = 40960;
__device__ __forceinline__ bf16x8 lds_rd16(LAS const unsigned char* p) { return *(LAS const bf16x8*)p; }
__device__ __forceinline__ float max3f_(float a, float b, float c) { float r; asm("v_max3_f32 %0, %1, %2, %3" : "=v"(r) : "v"(a), "v"(b), "v"(c)); return r; }
__device__ __forceinline__ v4i16_t lds_tr(LAS const unsigned char* p) { return __builtin_amdgcn_ds_read_tr16_b64_v4i16((LAS v4i16_t*)p); }

__device__ __forceinline__ void attn_phase(const Ptrs& P, LAS unsigned char* lds, int vcu) {
    const int tid = threadIdx.x, lane = tid & 63, wid = __builtin_amdgcn_readfirstlane(tid >> 6), r32 = lane & 31, hi = lane >> 5;
    const bf16_t* QI = (const bf16_t*)(P.ws + WS_QIMG); const bf16_t* KN = (const bf16_t*)(P.ws + WS_RA); const bf16_t* KPE = (const bf16_t*)(P.ws + WS_KPE); const bf16_t* VI = (const bf16_t*)(P.ws + WS_VIMG);
    bf16_t* A2 = (bf16_t*)(P.ws + WS_A2);
    const int bh = vcu >> 1, b = bh >> 3, head = bh & 7;
    const bf16_t* kn_b = KN + (size_t)bh * 64 * 4096 + lane * 8; const bf16_t* kpe_b = KPE + (size_t)b * 64 * 2048 + lane * 8; const bf16_t* v_b = VI + (size_t)bh * 256 * 1024 + lane * 8;
    LAS unsigned char* const wz = lds + 2 * ATT_STAGE + wid * 8192;
    const int vb = 24576 + (4 * hi + ((lane & 15) >> 2)) * 64 + ((lane >> 4) & 1) * 32 + (lane & 3) * 8;
#define ISSUE_TILE(t, st) do { _Pragma("unroll") for (int i_ = 0; i_ < 5; ++i_) { const int c_ = wid * 5 + i_; \
        const bf16_t* g_ = c_ < 16 ? kn_b + (size_t)(t) * 8192 + c_ * 512 : (c_ < 24 ? kpe_b + (size_t)(t) * 4096 + (c_ - 16) * 512 : v_b + (size_t)(t) * 8192 + (c_ - 24) * 512); \
        __builtin_amdgcn_global_load_lds((const unsigned*)g_, (LAS unsigned*)(lds + (st) * ATT_STAGE + c_ * 1024), 16, 0, 0); } } while (0)
#define QB_OF(ui) ((vcu & 1) ? ((ui) == 0 ? 5 : (ui) == 1 ? 2 : (ui) == 2 ? 4 : 3) : ((ui) == 0 ? 7 : (ui) == 1 ? 0 : (ui) == 2 ? 6 : 1))
#define LOAD_QF(qw_) do { const bf16_t* qp = QI + ((size_t)(bh * 64 + ((qw_) >> 5))) * 6144 + lane * 8; \
        _Pragma("unroll") for (int ks = 0; ks < 12; ++ks) qf[ks] = *(const bf16x8*)(qp + ks * 512); } while (0)
    bf16x8 qf[12];
    ISSUE_TILE(0, 0);
    LOAD_QF(QB_OF(0) * 256 + 32 * wid);
    for (int ui = 0; ui < 4; ++ui) {
        const int qb = QB_OF(ui);
        const int q0 = qb * 256, NT = 4 * (qb + 1), qw = q0 + 32 * wid;
        { const bf16_t* zsrc = A2 + (size_t)(b * SEQ + qw) * 2048 + 1024 + head * 128;
          int lp = lane; asm volatile("" : "+v"(lp));
#pragma unroll
          for (int c = 0; c < 8; ++c) { const int r = c * 4 + (lp >> 4), k = (lp & 15) ^ (r & 15);
              __builtin_amdgcn_global_load_lds((const unsigned*)(zsrc + (size_t)r * 2048 + k * 8), (LAS unsigned*)(wz + c * 1024), 16, 0, 0); } }
        f32x16 o[4];
#pragma unroll
        for (int d = 0; d < 4; ++d)
#pragma unroll
            for (int i = 0; i < 16; ++i) o[d][i] = 0.f;
        float mrun = 0.f, lrun = 0.f; f32x16 negmv;
#pragma unroll
        for (int i = 0; i < 16; ++i) negmv[i] = 0.f;
        for (int t = 0; t < NT; ++t) {
            asm volatile("s_waitcnt vmcnt(0)" ::: "memory");
            __syncthreads();
            if (t + 1 < NT) ISSUE_TILE(t + 1, (t + 1) & 1); else if (ui + 1 < 4) ISSUE_TILE(0, 0);
            if (64 * t <= qw) {
                LAS const unsigned char* st = lds + (t & 1) * ATT_STAGE;
                f32x16 p0, p1;
#define KOFF0(ks) ((ks) < 8 ? (ks) * 1024 : 16384 + ((ks) - 8) * 1024)
#define KOFF1(ks) ((ks) < 8 ? (8 + (ks)) * 1024 : 16384 + (4 + (ks) - 8) * 1024)
                { constexpr int PD = 4;
                  bf16x8 ka[12], kb[12];
#pragma unroll
                  for (int ks = 0; ks < PD; ++ks) { ka[ks] = lds_rd16(st + KOFF0(ks) + lane * 16); kb[ks] = lds_rd16(st + KOFF1(ks) + lane * 16); }
                  __builtin_amdgcn_sched_barrier(0);
#pragma unroll
                  for (int ks = 0; ks < 12; ++ks) {
                      if (ks + PD < 12) { ka[ks + PD] = lds_rd16(st + KOFF0(ks + PD) + lane * 16); kb[ks + PD] = lds_rd16(st + KOFF1(ks + PD) + lane * 16); }
                      p0 = __builtin_amdgcn_mfma_f32_32x32x16_bf16(ka[ks], qf[ks], ks == 0 ? negmv : p0, 0, 0, 0);
                      p1 = __builtin_amdgcn_mfma_f32_32x32x16_bf16(kb[ks], qf[ks], ks == 0 ? negmv : p1, 0, 0, 0);
                      __builtin_amdgcn_sched_barrier(0);
                  } }
#undef KOFF0
#undef KOFF1
                if (64 * t + 63 > qw) {
                    const int qa = qw + r32 - 64 * t - 4 * hi;
#pragma unroll
                    for (int i = 0; i < 16; ++i) { const int kv = (i & 3) + 8 * (i >> 2); if (kv > qa) p0[i] = -INFINITY; if (kv + 32 > qa) p1[i] = -INFINITY; }
                }
                float rm = max3f_(p0[0], p1[0], p0[1]);
                rm = max3f_(rm, p1[1], p0[2]);
#pragma unroll
                for (int i = 2; i < 15; ++i) rm = max3f_(rm, p1[i], p0[i + 1]);
                rm = fmaxf(rm, p1[15]);
                { auto rr = __builtin_amdgcn_permlane32_swap(__float_as_uint(rm), __float_as_uint(rm), false, false); rm = fmaxf(__uint_as_float(rr[0]), __uint_as_float(rr[1])); }
                if (t == 0 || __any(rm > 8.0f)) {
                    const float dl = t == 0 ? rm : fmaxf(rm, 0.f), alpha = __builtin_amdgcn_exp2f(-dl);
                    mrun = (t == 0 ? 0.f : mrun) + dl;
#pragma unroll
                    for (int i = 0; i < 16; ++i) { p0[i] -= dl; p1[i] -= dl; negmv[i] = -mrun; }
                    if (t != 0) { lrun *= alpha;
#pragma unroll
                        for (int d = 0; d < 4; ++d)
#pragma unroll
                            for (int i = 0; i < 16; ++i) o[d][i] *= alpha;
                    }
                }
                float ls = 0.f;
#pragma unroll
                for (int s = 0; s < 4; ++s) {
                    float e[8];
#pragma unroll
                    for (int j = 0; j < 8; ++j) { e[j] = __builtin_amdgcn_exp2f(s < 2 ? p0[8 * (s & 1) + j] : p1[8 * (s & 1) + j]); }
                    ls += ((e[0] + e[1]) + (e[2] + e[3])) + ((e[4] + e[5]) + (e[6] + e[7]));
                    u32x4 pw; pw.x = pk2(e[0], e[1]); pw.y = pk2(e[2], e[3]); pw.z = pk2(e[4], e[5]); pw.w = pk2(e[6], e[7]);
                    const bf16x8 pb = __builtin_bit_cast(bf16x8, pw);
#pragma unroll
                    for (int d = 0; d < 4; ++d) {
                        const v4i16_t lo = lds_tr(st + vb + ((2 * s) * 4 + d) * 512), hv = lds_tr(st + vb + ((2 * s + 1) * 4 + d) * 512);
                        const bf16x8 va = {lo[0], lo[1], lo[2], lo[3], hv[0], hv[1], hv[2], hv[3]};
                        o[d] = __builtin_amdgcn_mfma_f32_32x32x16_bf16(va, pb, o[d], 0, 0, 0);
                    }
                }
                lrun += ls;
            }
        }
        { auto rr = __builtin_amdgcn_permlane32_swap(__float_as_uint(lrun), __float_as_uint(lrun), false, false); lrun = __uint_as_float(rr[0]) + __uint_as_float(rr[1]); }
        if (ui + 1 < 4) LOAD_QF(QB_OF(ui + 1) * 256 + 32 * wid);
        const float inv = 1.0f / lrun;
        int rq = r32; asm volatile("" : "+v"(rq));
#pragma unroll
        for (int d = 0; d < 4; ++d)
#pragma unroll
            for (int g = 0; g < 4; ++g) {
                LAS u32x2* zp = (LAS u32x2*)(wz + (rq * 16 + ((4 * d + g) ^ (rq & 15))) * 16 + 8 * hi);
                const u32x2 z = *zp;
                u32x2 w; w.x = pk2(o[d][4 * g] * inv * bf_lo(z.x), o[d][4 * g + 1] * inv * bf_hi(z.x)); w.y = pk2(o[d][4 * g + 2] * inv * bf_lo(z.y), o[d][4 * g + 3] * inv * bf_hi(z.y));
                *zp = w;
            }
        { bf16_t* obase = A2 + (size_t)(b * SEQ + qw) * 2048 + 1024 + head * 128;
          int ln = lane; asm volatile("" : "+v"(ln));
#pragma unroll
          for (int i = 0; i < 8; ++i) { const int r = i * 4 + (ln >> 4), k = (ln & 15) ^ (r & 15);
              const u32x4 v = *(LAS const u32x4*)(wz + (i * 64 + ln) * 16);
              *(u32x4*)(obase + (size_t)r * 2048 + k * 8) = v; } }
    }
#undef ISSUE_TILE
#undef QB_OF
#undef LOAD_QF
    asm volatile("s_waitcnt vmcnt(0)" ::: "memory");
    __syncthreads();
}

#define XB_TMO      128
#define XB_XCNT(j)  (256  + 64 * (j))
#define XB_XSUB(j)  (1280 + 64 * (j))
#define XB_XGEN(j)  (2304 + 64 * (j))
#define XB_TOP      3328
#define XB_TOPGEN   3392
#define XCD_BAR_WORDS 3456
#define XB_SPIN_CAP (1u << 18)

__device__ __forceinline__ unsigned xb_ld(unsigned* p)              { return __hip_atomic_load(p, __ATOMIC_RELAXED, __HIP_MEMORY_SCOPE_AGENT); }
__device__ __forceinline__ unsigned xb_add(unsigned* p, unsigned v) { return __hip_atomic_fetch_add(p, v, __ATOMIC_RELAXED, __HIP_MEMORY_SCOPE_AGENT); }
__device__ __forceinline__ unsigned xb_xcc_id() { return (unsigned)__builtin_amdgcn_s_getreg((3 << 11) | 20) & 0xFu; }
#define XB_SPIN(cond, bar) do { unsigned _sp = 0; while (cond) { __builtin_amdgcn_s_sleep(1); \
    if ((++_sp & 255u) == 0u) { if (xb_ld(&(bar)[XB_TMO])) break; if (_sp > XB_SPIN_CAP) { atomicAdd(&(bar)[XB_TMO], 1u); break; } } } } while (0)

struct XcdBarrier {
    unsigned* bar; unsigned x;
    volatile LAS unsigned* st;
};

__device__ __forceinline__ XcdBarrier xcd_barrier_post(unsigned* bar, volatile LAS unsigned* st) {
    XcdBarrier b; b.bar = bar; b.x = xb_xcc_id(); b.st = st;
    if (threadIdx.x == 0) (void)xb_add(&bar[XB_XCNT(b.x)], 1u);
    return b;
}
__device__ __forceinline__ void xcd_barrier_complete(unsigned* bar, unsigned x, unsigned& nloc, unsigned& nx) {
    const unsigned G = gridDim.x * gridDim.y * gridDim.z;
    unsigned sum, cnt, mine, sp = 0u;
    for (;;) {
        sum = 0u; cnt = 0u; mine = 0u;
#pragma unroll
        for (unsigned j = 0; j < 16; ++j) { const unsigned c = xb_ld(&bar[XB_XCNT(j)]); sum += c; cnt += (c > 0u) ? 1u : 0u; mine = (j == x) ? c : mine; }
        if (sum == G) break;
        __builtin_amdgcn_s_sleep(1);
        if ((++sp & 255u) == 0u) { if (xb_ld(&bar[XB_TMO])) break; if (sp > XB_SPIN_CAP) { atomicAdd(&bar[XB_TMO], 1u); break; } }
    }
    nloc = mine > 0u ? mine : 1u; nx = cnt > 0u ? cnt : 1u;
}

__device__ __forceinline__ void xcd_barrier(const XcdBarrier& b) {
    asm volatile("s_waitcnt vmcnt(0)" ::: "memory");
    __syncthreads();
    if (threadIdx.x == 0) {
        unsigned* bar = b.bar;
        __builtin_amdgcn_s_waitcnt(0);
        unsigned nloc = b.st[0], nx = b.st[1];
        if (nloc == 0u) { xcd_barrier_complete(bar, b.x, nloc, nx); b.st[0] = nloc; b.st[1] = nx; }
        const unsigned old = xb_add(&bar[XB_XSUB(b.x)], 1u);
        const unsigned gen = old / nloc;
        if (old + 1u == (gen + 1u) * nloc) {
            __builtin_amdgcn_fence(__ATOMIC_RELEASE, "agent");
            asm volatile("s_waitcnt vmcnt(0)" ::: "memory");
            const unsigned og = xb_add(&bar[XB_TOP], 1u);
            const unsigned tg = og / nx;
            if (og + 1u == (tg + 1u) * nx) xb_add(&bar[XB_TOPGEN], 1u);
            else XB_SPIN(xb_ld(&bar[XB_TOPGEN]) == tg, bar);
            __builtin_amdgcn_fence(__ATOMIC_ACQUIRE, "agent");
            xb_add(&bar[XB_XGEN(b.x)], 1u);
            asm volatile("s_waitcnt vmcnt(0)" ::: "memory");
        } else {
            XB_SPIN(xb_ld(&bar[XB_XGEN(b.x)]) == gen, bar);
            __builtin_amdgcn_fence(__ATOMIC_ACQUIRE, "agent");
            asm volatile("s_waitcnt vmcnt(0)" ::: "memory");
        }
    }
    __syncthreads();
}

struct Args { const float* in[16]; float* out; unsigned char* ws; int ph_lo, ph_hi; };
constexpr int NPHASE = 8;
#ifndef MK_LAUNCHES
#define MK_LAUNCHES 1
#endif

__global__ void __launch_bounds__(512, 2) fwd_kernel(Args a) {
    extern __shared__ __attribute__((aligned(16))) unsigned char lds_raw[];
    LAS unsigned char* lds = (LAS unsigned char*)lds_raw;
    const int G = gridDim.x, bx = blockIdx.x;
    const int vcu = (G % 8 == 0) ? (bx % 8) * (G / 8) + bx / 8 : bx;
    Ptrs P;
    P.x = a.in[0]; P.c = a.in[1]; P.positions = (const int*)a.in[2]; P.w_ada = a.in[3]; P.b_ada = a.in[4]; P.g_pre = a.in[5]; P.w_in = a.in[6]; P.conv_w = a.in[7]; P.w_conv_out = a.in[8];
    P.g_q = a.in[9]; P.w_uq = a.in[10]; P.g_kv = a.in[11]; P.w_ukv = a.in[12]; P.w_mla_out = a.in[13]; P.w_out = a.in[14]; P.g_post = a.in[15]; P.out = a.out; P.ws = a.ws;
    const int lo = a.ph_lo, hi = a.ph_hi; (void)lo; (void)hi;
    volatile LAS unsigned* bst = (volatile LAS unsigned*)(lds + 147456 + 64);
    if (threadIdx.x < 2) bst[threadIdx.x] = 0u;
    __syncthreads();
    XcdBarrier bar = xcd_barrier_post((unsigned*)(P.ws + WS_BAR), bst);
    if (a.ph_hi > NPHASE) cg::this_grid().sync();
#ifndef PHMASK
#define PHMASK 0xff
#endif
#define IN(k) (((PHMASK >> (k)) & 1) && lo <= (k) && (k) < hi)
#define SEAM(k) do { if (IN(k) && IN((k) + 1)) { xcd_barrier(bar); } } while (0)
    float* ssq = (float*)(P.ws + WS_SSQ);
    const float* rope = (const float*)(P.ws + WS_ROPE);
    if (IN(0)) { phase0(P, lds, G); }
    if (IN(1)) { phase1(P, G); } SEAM(1);
    if (IN(2)) {
        { pg8::Gemm g{(const bf16_t*)(P.ws + WS_H), (const bf16_t*)(P.ws + WS_WIN), T, 5888, DM}; pg8::StaticOrder S; S.init(T, 5888, G, bx);
          EpiInProj E{P.ws, P.out};
          pg8::gemm_phase<EpiInProj, pg8::StaticOrder, true, true>(lds, g, S, E); }
        xcd_barrier(bar);
        const int flip = (bx >> 3) & 1;
#define RUN_CONV() do { pg8::Gemm g{(const bf16_t*)(P.ws + WS_H), (const bf16_t*)(P.ws + WS_WIN) + (size_t)5888 * DM, T, 2048, DM}; pg8::StaticOrder S; S.init(T, 2048, G, bx); \
            EpiConv E{P.ws, P.conv_w}; pg8::gemm_phase<EpiConv, pg8::StaticOrder, true, true>(lds, g, S, E); } while (0)
#define RUN_KVUP() do { pg8::Gemm g{(const bf16_t*)(P.ws + WS_KVL), (const bf16_t*)(P.ws + WS_WUKV), T, 2048, KVLORA}; pg8::StaticOrder S; S.init(T, 2048, G, bx); \
            EpiKVUp E{P.ws}; pg8::gemm_phase<EpiKVUp, pg8::StaticOrder, true, true>(lds, g, S, E); } while (0)
        if (flip) { RUN_KVUP(); RUN_CONV(); } else { RUN_CONV(); RUN_KVUP(); }
#undef RUN_CONV
#undef RUN_KVUP
        xcd_barrier(bar);
        { pg8::Gemm g{(const bf16_t*)(P.ws + WS_QL), (const bf16_t*)(P.ws + WS_WUQ), T, 1536, QLORA}; pg8::StaticOrder S; S.init(T, 1536, G, bx);
          EpiQUp E{P.ws};
          pg8::gemm_phase<EpiQUp, pg8::StaticOrder, true, true>(lds, g, S, E); }
    } SEAM(3);
    if (IN(4)) { for (int v = vcu; v < 256; v += G) attn_phase(P, lds, v); } SEAM(4);
    if (IN(5)) {
        pg8::Gemm g{(const bf16_t*)(P.ws + WS_A2), (const bf16_t*)(P.ws + WS_WM), T, DM, 2048}; pg8::StaticOrder S; S.init(T, DM, G, bx);
        EpiMerge E{P.ws, P.out};
        pg8::gemm_phase<EpiMerge, pg8::StaticOrder, true, true>(lds, g, S, E);
    } SEAM(5);
    if (IN(6)) {
        pg8::Gemm g{(const bf16_t*)(P.ws + WS_RA), (const bf16_t*)(P.ws + WS_WOUT), T, DM, DM}; pg8::StaticOrder S; S.init(T, DM, G, bx);
        EpiOut E{P.ws};
        pg8::gemm_phase<EpiOut, pg8::StaticOrder, true, true>(lds, g, S, E);
    } SEAM(6);
    if (IN(7)) { final_pass(P, G); }
#undef IN
#undef SEAM
}

extern "C" void kernel_launch(void* const* d_in, const int* in_sizes, int n_in, void* d_out, int out_size, void* d_ws, size_t ws_size, hipStream_t stream) {
    static int grid = 0;
    if (grid == 0) {
        if (n_in != 16 || in_sizes[0] != T * DM || out_size != T * DM || ws_size < WS_END) { fprintf(stderr, "kernel_launch: unexpected shapes: n_in %d in0 %d out %d ws %zu (need %zu)\n", n_in, n_in > 0 ? in_sizes[0] : -1, out_size, ws_size, (size_t)WS_END); grid = -1; return; }
        int dev = 0, cus = 0, per_cu = 0;
        hipGetDevice(&dev); hipDeviceGetAttribute(&cus, hipDeviceAttributeMultiprocessorCount, dev);
        if (hipFuncSetAttribute((const void*)fwd_kernel, hipFuncAttributeMaxDynamicSharedMemorySize, LDS_BYTES) != hipSuccess) { fprintf(stderr, "kernel_launch: hipFuncSetAttribute failed\n"); grid = -1; return; }
        if (hipOccupancyMaxActiveBlocksPerMultiprocessor(&per_cu, (const void*)fwd_kernel, 512, LDS_BYTES) != hipSuccess || per_cu < 1) { fprintf(stderr, "kernel_launch: occupancy query says %d\n", per_cu); per_cu = 1; }
        (void)hipGetLastError();
        grid = cus * 1;
        if (grid <= 0) grid = 256;
    }
    if (grid < 0) return;
    if (hipMemsetAsync((char*)d_ws + WS_BAR, 0, 16384, stream) != hipSuccess) { fprintf(stderr, "kernel_launch: memset failed\n"); return; }
    Args a{};
    for (int i = 0; i < 16; ++i) a.in[i] = (const float*)d_in[i];
    a.out = (float*)d_out; a.ws = (unsigned char*)d_ws;
#if MK_LAUNCHES == 1
    a.ph_lo = 0; a.ph_hi = NPHASE;
    void* args[] = {&a};
    hipError_t e = hipLaunchCooperativeKernel((const void*)fwd_kernel, dim3(grid), dim3(512), args, LDS_BYTES, stream);
    if (e != hipSuccess) fprintf(stderr, "cooperative launch failed: %s (grid %d)\n", hipGetErrorString(e), grid);
#else
    for (int p = 0; p < NPHASE; ++p) { a.ph_lo = p; a.ph_hi = p + 1; hipLaunchKernelGGL(fwd_kernel, dim3(grid), dim3(512), LDS_BYTES, stream, a); }
#endif
}
```
